# Optimizing an MI355X kernel written in HIP

```python
import math
import jax
import jax.numpy as jnp
from jax import lax
import numpy as np

D_MODEL = 1024
BATCH = 8
SEQ = 2048
DEPTH = 2
DEC_BATCH = 128
DEC_SEQ = 8
PAST_LEN = 16384
PAGE_SIZE = 128

MIX_WIDTH = D_MODEL
HGRN_WIDTH = MIX_WIDTH // 2
CONV_WIDTH = MIX_WIDTH - HGRN_WIDTH
HGRN_HEAD_DIM = 128
HGRN_HEADS = HGRN_WIDTH // HGRN_HEAD_DIM
CONV_K = 3
D_FF = 4 * D_MODEL
CHUNK = 64
PROJ_WIDTH = 4 * HGRN_WIDTH + 3 * CONV_WIDTH
SPLITS = (HGRN_WIDTH, 2 * HGRN_WIDTH, 3 * HGRN_WIDTH, 4 * HGRN_WIDTH,
          4 * HGRN_WIDTH + CONV_WIDTH, 4 * HGRN_WIDTH + 2 * CONV_WIDTH)
ALPHA = float((2 * DEPTH) ** 0.25)
BETA = float((8 * DEPTH) ** -0.25)
LN_EPS = 1e-5
RMS_EPS = 1e-6

kernel_name = "hgrn2_shortconv_hybrid_step"


def _layer_norm(x, g, b):
    xf = x.astype(jnp.float32)
    mu = jnp.mean(xf, axis=-1, keepdims=True)
    xc = xf - mu
    var = jnp.mean(xc * xc, axis=-1, keepdims=True)
    y = xc * lax.rsqrt(var + LN_EPS) * g.astype(jnp.float32) + b.astype(jnp.float32)
    return y.astype(x.dtype)


def _hgrn2(q, log_f, k, v, s0):
    bsz, t_len, n_h, d_k = q.shape
    d_v = v.shape[-1]
    c = math.gcd(t_len, CHUNK)
    n = t_len // c

    def to_chunks(a):
        return jnp.moveaxis(a.reshape(bsz, n, c, *a.shape[2:]), 1, 0)

    causal = jnp.tril(jnp.ones((c, c), dtype=bool))[None, :, :, None, None]

    def step(s_prev, inp):
        qc, lfc, kc, vc = inp
        b = jnp.cumsum(lfc, axis=1)
        o_inter = jnp.einsum('bthk,bhkv->bthv', qc * jnp.exp(b), s_prev)
        diff = b[:, :, None] - b[:, None, :]
        decay = jnp.exp(jnp.where(causal, diff, -jnp.inf))
        scores = jnp.einsum('bthk,btshk,bshk->bhts', qc, decay, kc)
        o_intra = jnp.einsum('bhts,bshv->bthv', scores, vc)
        b_last = b[:, -1]
        k_dec = kc * jnp.exp(b_last[:, None] - b)
        s_new = jnp.exp(b_last)[..., None] * s_prev + jnp.einsum('bshk,bshv->bhkv', k_dec, vc)
        return s_new, o_inter + o_intra

    s_fin, o = lax.scan(step, s0, (to_chunks(q), to_chunks(log_f), to_chunks(k), to_chunks(v)))
    o = jnp.moveaxis(o, 0, 1).reshape(bsz, t_len, n_h, d_v)
    return o, s_fin


def _layer(x, s_hgrn, conv_buf, lb, w_in, conv_w, onorm_g, w_out,
           ln1_g, ln1_b, w_ff1, w_ff2, ln2_g, ln2_b):
    bsz, t_len, _ = x.shape
    f32 = jnp.float32
    proj = jnp.einsum('btd,dp->btp', x, w_in)
    q, f_pre, i_val, g, gate_b, gate_c, h = jnp.split(proj, SPLITS, axis=-1)

    shp = (bsz, t_len, HGRN_HEADS, HGRN_HEAD_DIM)
    qh = jax.nn.silu(q.astype(f32)).reshape(shp)
    lbh = lb.reshape(HGRN_HEADS, HGRN_HEAD_DIM)
    log_f = jnp.logaddexp(jnp.log(lbh), jnp.log1p(-lbh) + jax.nn.log_sigmoid(f_pre.astype(f32).reshape(shp)))
    kh = -jnp.expm1(log_f)
    vh = i_val.astype(f32).reshape(shp)
    o, s_new = _hgrn2(qh, log_f, kh, vh, s_hgrn.astype(f32))
    o = o * lax.rsqrt(jnp.mean(o * o, axis=-1, keepdims=True) + RMS_EPS)
    o = o.reshape(bsz, t_len, HGRN_WIDTH) * onorm_g.astype(f32) * jax.nn.silu(g.astype(f32))

    u = gate_c * h
    full = jnp.concatenate([conv_buf.astype(u.dtype), u], axis=1)
    conv_out = sum(conv_w[j] * full[:, j:j + t_len] for j in range(CONV_K))
    yc = gate_b * conv_out
    new_buf = full[:, t_len:]

    mix = jnp.einsum('btm,md->btd', jnp.concatenate([o.astype(x.dtype), yc], axis=-1), w_out)
    x = _layer_norm(ALPHA * x + mix, ln1_g, ln1_b)

    hid = jnp.square(jax.nn.relu(jnp.einsum('btd,df->btf', x, w_ff1)))
    x = _layer_norm(ALPHA * x + jnp.einsum('btf,fd->btd', hid, w_ff2), ln2_g, ln2_b)
    return x, s_new, new_buf


def setup_inputs(seed: int = 0) -> dict:
    key = jax.random.key(seed)
    ks = jax.random.split(key, 16)
    nrm = jax.random.normal
    x_prompt = nrm(ks[0], (BATCH, SEQ, D_MODEL), jnp.float32)
    x_sample = nrm(ks[1], (DEC_BATCH, DEC_SEQ, D_MODEL), jnp.float32)
    state_hgrn = 0.5 * nrm(ks[2], (DEPTH, DEC_BATCH, HGRN_HEADS, HGRN_HEAD_DIM, HGRN_HEAD_DIM), jnp.float32)
    state_conv = 0.5 * nrm(ks[3], (DEPTH, DEC_BATCH, CONV_K - 1, CONV_WIDTH), jnp.float32)
    col_scale = jnp.concatenate([
        jnp.ones((2 * HGRN_WIDTH,), jnp.float32), jnp.full((HGRN_WIDTH,), BETA, jnp.float32),
        jnp.ones((HGRN_WIDTH + 2 * CONV_WIDTH,), jnp.float32), jnp.full((CONV_WIDTH,), BETA, jnp.float32)])
    w_in = nrm(ks[4], (DEPTH, D_MODEL, PROJ_WIDTH), jnp.float32) * (D_MODEL ** -0.5) * col_scale
    lb_logits = nrm(ks[5], (DEPTH, HGRN_WIDTH), jnp.float32)
    conv_w = nrm(ks[6], (DEPTH, CONV_K, CONV_WIDTH), jnp.float32) * (CONV_K ** -0.5)
    onorm_g = 1.0 + 0.01 * nrm(ks[7], (DEPTH, HGRN_WIDTH), jnp.float32)
    w_out = nrm(ks[8], (DEPTH, MIX_WIDTH, D_MODEL), jnp.float32) * (MIX_WIDTH ** -0.5) * BETA
    ln1_g = 1.0 + 0.01 * nrm(ks[9], (DEPTH, D_MODEL), jnp.float32)
    ln1_b = 0.01 * nrm(ks[10], (DEPTH, D_MODEL), jnp.float32)
    w_ff1 = nrm(ks[11], (DEPTH, D_MODEL, D_FF), jnp.float32) * (D_MODEL ** -0.5) * BETA
    w_ff2 = nrm(ks[12], (DEPTH, D_FF, D_MODEL), jnp.float32) * (D_FF ** -0.5) * BETA
    ln2_g = 1.0 + 0.01 * nrm(ks[13], (DEPTH, D_MODEL), jnp.float32)
    ln2_b = 0.01 * nrm(ks[14], (DEPTH, D_MODEL), jnp.float32)
    return {"x_prompt": x_prompt, "x_sample": x_sample,
            "state_hgrn": state_hgrn, "state_conv": state_conv,
            "w_in": w_in, "lb_logits": lb_logits, "conv_w": conv_w, "onorm_g": onorm_g,
            "w_out": w_out, "ln1_g": ln1_g, "ln1_b": ln1_b,
            "w_ff1": w_ff1, "w_ff2": w_ff2, "ln2_g": ln2_g, "ln2_b": ln2_b}


def reference(x_prompt, x_sample, state_hgrn, state_conv, w_in, lb_logits, conv_w, onorm_g,
              w_out, ln1_g, ln1_b, w_ff1, w_ff2, ln2_g, ln2_b):
    p = jax.nn.softmax(lb_logits.astype(jnp.float32), axis=0)
    cum = jnp.cumsum(p, axis=0)
    lower_bounds = cum - cum[0:1]

    yp, ys = x_prompt, x_sample
    hp_list, cp_list, hs_list, cs_list = [], [], [], []
    for l in range(DEPTH):
        weights = (w_in[l], conv_w[l], onorm_g[l], w_out[l], ln1_g[l], ln1_b[l],
                   w_ff1[l], w_ff2[l], ln2_g[l], ln2_b[l])
        s0 = jnp.zeros((BATCH, HGRN_HEADS, HGRN_HEAD_DIM, HGRN_HEAD_DIM), jnp.float32)
        b0 = jnp.zeros((BATCH, CONV_K - 1, CONV_WIDTH), x_prompt.dtype)
        yp, hp, cp = _layer(yp, s0, b0, lower_bounds[l], *weights)
        ys, hs, cs = _layer(ys, state_hgrn[l], state_conv[l], lower_bounds[l], *weights)
        hp_list.append(hp.astype(x_prompt.dtype))
        cp_list.append(cp.astype(x_prompt.dtype))
        hs_list.append(hs.astype(state_hgrn.dtype))
        cs_list.append(cs.astype(state_conv.dtype))
    new_hgrn_prompt = jnp.stack(hp_list, axis=0)
    new_conv_prompt = jnp.stack(cp_list, axis=0)
    new_hgrn_sample = jnp.stack(hs_list, axis=0)
    new_conv_sample = jnp.stack(cs_list, axis=0)
    return (yp, ys, new_hgrn_prompt, new_conv_prompt, new_hgrn_sample, new_conv_sample)
```

```cpp
#include <hip/hip_runtime.h>
#include <hip/hip_cooperative_groups.h>
#include <cstdio>
#include <cstdint>
namespace cg = cooperative_groups;
#define MK_N_LAUNCHES 1
namespace pg8 {
#define PG8_LAS __attribute__((address_space(3)))
typedef unsigned short bf16_t;
typedef short bf16x8 __attribute__((ext_vector_type(8)));
typedef float f32x4 __attribute__((ext_vector_type(4)));
typedef unsigned u32x4 __attribute__((ext_vector_type(4)));
constexpr int BM = 256, BK = 64, HALF = 128, HTB = HALF * BK * 2  , STAGE_BYTES = 8 * HTB, NXCD = 8, WGM = 8;

__host__ __device__ __forceinline__ int lds_byte(int r, int c) { const int st = (r >> 4) * 2 + (c >> 5), rr = r & 15, cc = c & 31, ob = rr * 64 + cc * 2; return st * 1024 + (ob ^ (((ob >> 9) & 1) << 5)); }
__host__ __device__ __forceinline__ void stage_rc(int b, int& R, int& C) { const int st = b / 1024, sb = b % 1024, swz = sb ^ (((sb >> 9) & 1) << 5); R = (st >> 1) * 16 + swz / 64; C = (st & 1) * 32 + (swz % 64) / 2; }
__host__ __device__ __forceinline__ int perm32(int rho) { const int n = rho >> 4, i = rho & 15; return 8 * (i >> 2) + 4 * n + (i & 3); }

struct Unit { int pm, pn; };
struct Gemm { const bf16_t* A; const bf16_t* Bt; int M, N, K; };

struct StaticOrder {
    int nM, nN, nwg, G, c;
    __host__ __device__ void init(int M, int N, int G_, int c_) { nM = M / BM; nN = N / BM; nwg = nM * nN; G = G_; c = c_; }
    __host__ __device__ bool next(int i, Unit& u) const {
        const long L = (long)i * G + c; if (L >= nwg) return false;
        int wgid = (int)L; { const int q = nwg / NXCD, r = nwg % NXCD, xcd = wgid % NXCD, off = wgid / NXCD; wgid = (xcd < r ? xcd * (q + 1) : r * (q + 1) + (xcd - r) * q) + off; }
        const int nig = WGM * nN, gid = wgid / nig, fm = gid * WGM, gsz = (nM - fm) < WGM ? (nM - fm) : WGM;
        u.pm = fm + ((wgid % nig) % gsz); u.pn = (wgid % nig) / gsz; return true;
    }
    __device__ __forceinline__ void a_ready(const Unit&) const {}
    __device__ __forceinline__ void done(const Unit&) const {}
};

__device__ __forceinline__ unsigned cvt_pk_bf16(float lo, float hi) { unsigned r; asm volatile("v_cvt_pk_bf16_f32 %0, %1, %2" : "=v"(r) : "v"(lo), "v"(hi)); return r; }
template <class Epi, class Sched, bool ALIGN_EPI = false, bool SP2 = false>
__device__ __forceinline__ void gemm_phase(PG8_LAS unsigned char* lds, const Gemm g, const Sched& S, const Epi& E) {
    int tid_ = threadIdx.x; asm volatile("" : "+v"(tid_));
    const int tid = tid_, wid = __builtin_amdgcn_readfirstlane(tid >> 6), lane = tid & 63, wr = wid >> 2, wc = wid & 3, fr = lane & 15, fq = lane >> 4;
    const int K = g.K, nt = K / BK;
    unsigned voffA[2], voffB[2];
#pragma unroll
    for (int i = 0; i < 2; ++i) { int R, C; stage_rc(tid * 16 + i * 8192, R, C); const int Rb = Epi::PERM ? ((R & ~31) + perm32(R & 31)) : R;
        voffA[i] = (unsigned)(R * K + C) * 2u; voffB[i] = (unsigned)(Rb * K + C) * 2u; }
    const size_t kstep = (size_t)(BK * 2);
    const size_t hstep = (size_t)HALF * K * 2;
    const size_t tstep = 2 * hstep;
    const unsigned ldsw = (unsigned)wid * 1024u;
    const int aoff = lds_byte(wr * 64 + fr, fq * 8), boff = lds_byte(wc * 32 + fr, fq * 8);
#define PG8_SA(b, h) (((b) * 2 + (h)) * HTB)
#define PG8_SB(b, h) ((4 + (b) * 2 + (h)) * HTB)
#define PG8_STAGE(bufoff, gbase, voff) do { _Pragma("unroll") for (int _i = 0; _i < 2; ++_i) \
        __builtin_amdgcn_global_load_lds((const unsigned*)((const char*)(gbase) + (voff)[_i]), (PG8_LAS unsigned*)(lds + (bufoff) + ldsw + _i * 8192), 16, 0, 0); } while (0)
#define PG8_LDA(dst, b, h) do { _Pragma("unroll") for (int m = 0; m < 4; ++m) _Pragma("unroll") for (int k = 0; k < 2; ++k) dst[m][k] = *(const PG8_LAS bf16x8*)(lds + PG8_SA(b, h) + aoff + m * 2048 + k * 1024); } while (0)
#define PG8_LDB(dst, b, h) do { _Pragma("unroll") for (int n = 0; n < 2; ++n) _Pragma("unroll") for (int k = 0; k < 2; ++k) dst[n][k] = *(const PG8_LAS bf16x8*)(lds + PG8_SB(b, h) + boff + n * 2048 + k * 1024); } while (0)
#define PG8_MMA(ai, bj, At, Bt) do { __builtin_amdgcn_s_setprio(1); _Pragma("unroll") for (int m = 0; m < 4; ++m) _Pragma("unroll") for (int n = 0; n < 2; ++n) _Pragma("unroll") for (int k = 0; k < 2; ++k) \
        acc[ai][bj][m][n] = __builtin_amdgcn_mfma_f32_16x16x32_bf16(Bt[n][k], At[m][k], acc[ai][bj][m][n], 0, 0, 0); __builtin_amdgcn_s_setprio(0); } while (0)
#define PG8_WAIT_V(n) asm volatile("s_waitcnt vmcnt(" #n ")" ::: "memory")
#define PG8_WAIT_L(n) asm volatile("s_waitcnt lgkmcnt(" #n ")" ::: "memory")
#define PG8_BAR __builtin_amdgcn_s_barrier()
#define PG8_SCHED __builtin_amdgcn_sched_barrier(0)
    Unit cur, nxt; int ui = 0;
    if (!S.next(0, cur)) return;
    f32x4 acc[2][2][4][2];
#pragma unroll
    for (int a = 0; a < 2; ++a)
#pragma unroll
        for (int b = 0; b < 2; ++b)
#pragma unroll
            for (int m = 0; m < 4; ++m)
#pragma unroll
                for (int n = 0; n < 2; ++n) acc[a][b][m][n] = (f32x4){0.f, 0.f, 0.f, 0.f};
    bf16x8 At[4][2], B0[2][2], B1[2][2];
    const char* cA = (const char*)g.A + (size_t)cur.pm * tstep; const char* cB = (const char*)g.Bt + (size_t)cur.pn * tstep;
    S.a_ready(cur);
    if constexpr (SP2) {
        PG8_STAGE(PG8_SB(0, 0), cB, voffB); PG8_STAGE(PG8_SB(0, 1), cB + hstep, voffB); PG8_STAGE(PG8_SA(0, 0), cA, voffA); PG8_STAGE(PG8_SA(0, 1), cA + hstep, voffA);
        if (wr == 1) PG8_BAR;
        PG8_WAIT_V(2); PG8_BAR;
        PG8_STAGE(PG8_SB(1, 0), cB + kstep, voffB); PG8_STAGE(PG8_SA(1, 0), cA + kstep, voffA); PG8_STAGE(PG8_SB(1, 1), cB + hstep + kstep, voffB);
        PG8_WAIT_V(6); PG8_BAR;
    } else {
        PG8_STAGE(PG8_SB(0, 0), cB, voffB); PG8_STAGE(PG8_SA(0, 0), cA, voffA); PG8_STAGE(PG8_SB(0, 1), cB + hstep, voffB); PG8_STAGE(PG8_SA(0, 1), cA + hstep, voffA);
        if (wr == 1) PG8_BAR;
        PG8_WAIT_V(4); PG8_BAR;
        PG8_STAGE(PG8_SB(1, 0), cB + kstep, voffB); PG8_STAGE(PG8_SA(1, 0), cA + kstep, voffA); PG8_STAGE(PG8_SB(1, 1), cB + hstep + kstep, voffB);
        PG8_WAIT_V(6); PG8_BAR;
    }
    for (;;) {
        const bool has_next = S.next(ui + 1, nxt);
        const char* nA = has_next ? (const char*)g.A + (size_t)nxt.pm * tstep : cA; const char* nB = has_next ? (const char*)g.Bt + (size_t)nxt.pn * tstep : cB;
        for (int t = 0; t < nt; t += 2) {
            const bool last = (t == nt - 2);
            const char* a1 = cA + (size_t)(t + 1) * kstep;
            const char* a2 = last ? nA : cA + (size_t)(t + 2) * kstep; const char* b2 = last ? nB : cB + (size_t)(t + 2) * kstep;
            const char* a3 = a2 + kstep; const char* b3 = b2 + kstep;
            if (last && has_next) S.a_ready(nxt);
            if constexpr (SP2) {
            PG8_LDB(B0, 0, 0); PG8_LDB(B1, 0, 1); PG8_SCHED; PG8_LDA(At, 0, 0); PG8_STAGE(PG8_SA(1, 1), a1 + hstep, voffA);
            PG8_WAIT_V(8); PG8_WAIT_L(0); PG8_BAR; PG8_MMA(0, 0, At, B0); PG8_MMA(0, 1, At, B1); PG8_BAR; PG8_SCHED;
            PG8_LDA(At, 0, 1); PG8_STAGE(PG8_SB(0, 0), b2, voffB); PG8_STAGE(PG8_SB(0, 1), b2 + hstep, voffB); PG8_STAGE(PG8_SA(0, 0), a2, voffA);
            PG8_WAIT_V(8); PG8_WAIT_L(0); PG8_BAR; PG8_MMA(1, 0, At, B0); PG8_MMA(1, 1, At, B1); PG8_BAR; PG8_SCHED;
            PG8_LDB(B0, 1, 0); PG8_LDB(B1, 1, 1); PG8_SCHED; PG8_LDA(At, 1, 0); PG8_STAGE(PG8_SA(0, 1), a2 + hstep, voffA);
            PG8_WAIT_V(8); PG8_WAIT_L(0); PG8_BAR; PG8_MMA(0, 0, At, B0); PG8_MMA(0, 1, At, B1); PG8_BAR; PG8_SCHED;
            PG8_LDA(At, 1, 1); PG8_STAGE(PG8_SB(1, 0), b3, voffB); PG8_STAGE(PG8_SB(1, 1), b3 + hstep, voffB); PG8_STAGE(PG8_SA(1, 0), a3, voffA);
            PG8_WAIT_V(8); PG8_WAIT_L(0); PG8_BAR; PG8_MMA(1, 0, At, B0); PG8_MMA(1, 1, At, B1); PG8_BAR; PG8_SCHED;
            } else {
            PG8_LDB(B0, 0, 0); PG8_SCHED; PG8_LDA(At, 0, 0); PG8_STAGE(PG8_SA(1, 1), a1 + hstep, voffA);
            PG8_WAIT_L(8); PG8_BAR; PG8_WAIT_L(0); PG8_MMA(0, 0, At, B0); PG8_BAR; PG8_SCHED;
            PG8_LDB(B1, 0, 1); PG8_STAGE(PG8_SB(0, 0), b2, voffB);
            PG8_BAR; PG8_WAIT_L(0); PG8_MMA(0, 1, At, B1); PG8_BAR;
            PG8_LDA(At, 0, 1); PG8_STAGE(PG8_SA(0, 0), a2, voffA);
            PG8_BAR; PG8_WAIT_L(0); PG8_MMA(1, 0, At, B0); PG8_BAR; PG8_SCHED;
            PG8_STAGE(PG8_SB(0, 1), b2 + hstep, voffB);
            PG8_WAIT_V(6); PG8_BAR; PG8_MMA(1, 1, At, B1); PG8_BAR;
            PG8_LDB(B0, 1, 0); PG8_SCHED; PG8_LDA(At, 1, 0); PG8_STAGE(PG8_SA(0, 1), a2 + hstep, voffA);
            PG8_WAIT_L(8); PG8_BAR; PG8_WAIT_L(0); PG8_MMA(0, 0, At, B0); PG8_BAR; PG8_SCHED;
            PG8_LDB(B1, 1, 1); PG8_STAGE(PG8_SB(1, 0), b3, voffB);
            PG8_BAR; PG8_WAIT_L(0); PG8_MMA(0, 1, At, B1); PG8_BAR;
            PG8_LDA(At, 1, 1); PG8_STAGE(PG8_SA(1, 0), a3, voffA);
            PG8_BAR; PG8_WAIT_L(0); PG8_MMA(1, 0, At, B0); PG8_BAR; PG8_SCHED;
            PG8_STAGE(PG8_SB(1, 1), b3 + hstep, voffB);
            PG8_WAIT_V(6); PG8_BAR; PG8_MMA(1, 1, At, B1); PG8_BAR;
            }
        }
        if constexpr (ALIGN_EPI) { if (wr == 0) PG8_BAR; }
        if constexpr (!Epi::AFTER_DRAIN) { E(acc, cur, wr, wc, fr, fq); S.done(cur); }
        if (!has_next) break;
#pragma unroll
        for (int a = 0; a < 2; ++a)
#pragma unroll
            for (int b = 0; b < 2; ++b)
#pragma unroll
                for (int m = 0; m < 4; ++m)
#pragma unroll
                    for (int n = 0; n < 2; ++n) acc[a][b][m][n] = (f32x4){0.f, 0.f, 0.f, 0.f};
        cur = nxt; cA = nA; cB = nB; ++ui;
        if constexpr (ALIGN_EPI) { if (wr == 1) PG8_BAR; }
    }
    PG8_WAIT_V(0);
    if constexpr (!ALIGN_EPI) { if (wr == 0) PG8_BAR; }
    PG8_BAR;
    if constexpr (Epi::AFTER_DRAIN) { E.fused(acc, cur, wr, wc, fr, fq, lds, wid, lane); S.done(cur); }
#undef PG8_SA
#undef PG8_SB
#undef PG8_STAGE
#undef PG8_LDA
#undef PG8_LDB
#undef PG8_MMA
#undef PG8_WAIT_V
#undef PG8_WAIT_L
#undef PG8_BAR
#undef PG8_SCHED
}
}

#ifndef PHMASK
#define PHMASK 1023
#endif
#ifndef MK_N_LAUNCHES
#define MK_N_LAUNCHES 1
#endif
#define LAS __attribute__((address_space(3)))
typedef unsigned short bf16;
typedef unsigned u32x4 __attribute__((ext_vector_type(4)));
typedef unsigned u32x2 __attribute__((ext_vector_type(2)));
typedef float f32x4 __attribute__((ext_vector_type(4)));
typedef short bf16x8 __attribute__((ext_vector_type(8)));
typedef LAS unsigned char* ldsp;

constexpr int TP = 16384, TS = 1024, TT = TP + TS, DM = 1024, FF = 4096, PW = 3584, HW = 512;
constexpr int SEQ = 2048, NCHUNK = 32, NPU = 1024  , NSU = 512  ;
constexpr float ALPHA = 1.4142135623730951f, LN_EPS = 1e-5f, RMS_EPS = 1e-6f;
constexpr size_t MiB = 1u << 20;
constexpr size_t WS_DEC = 1 * MiB, WS_W = 2 * MiB, W_LAYER = 25 * MiB, W_IN = 0, W_OUT = 7 * MiB, W_FF1 = 9 * MiB, W_FF2 = 17 * MiB;
constexpr size_t WS_XB = 52 * MiB, WS_MIX = 86 * MiB, WS_BIG = 120 * MiB;
constexpr size_t WS_QB = WS_BIG, WS_LF = WS_BIG + 17 * MiB, WS_VB = WS_BIG + 51 * MiB, WS_GB = WS_BIG + 68 * MiB, WS_BB = WS_BIG + 85 * MiB, WS_UB = WS_BIG + 102 * MiB;
constexpr size_t WS_HID = WS_BIG, WS_END = 256 * MiB;
constexpr size_t O_Y = 0, O_HP = (size_t)TT * DM, O_CP = O_HP + 2 * 8 * 4 * 16384, O_HS = O_CP + 2 * 8 * 2 * 512, O_CS = O_HS + (size_t)2 * 128 * 4 * 16384, O_END = O_CS + 2 * 128 * 2 * 512;
constexpr int LDS_BYTES = 147456;
constexpr int NPHASE = 19;

__device__ __forceinline__ float bflo(unsigned w) { return __uint_as_float(w << 16); }
__device__ __forceinline__ float bfhi(unsigned w) { return __uint_as_float(w & 0xffff0000u); }
__device__ __forceinline__ float bf1(bf16 h) { return __uint_as_float(((unsigned)h) << 16); }
__device__ __forceinline__ unsigned pk(float lo, float hi) { return pg8::cvt_pk_bf16(lo, hi); }
__device__ __forceinline__ bf16 tobf(float x) { return (bf16)(pg8::cvt_pk_bf16(x, 0.f) & 0xffffu); }
__device__ __forceinline__ float silu_f(float x) { return x / (1.f + __expf(-x)); }
__device__ __forceinline__ float wave_sum(float v) {
#pragma unroll
    for (int o = 1; o < 64; o <<= 1) v += __shfl_xor(v, o);
    return v;
}
#define MFMA16(a, b, c) __builtin_amdgcn_mfma_f32_16x16x32_bf16((a), (b), (c), 0, 0, 0)

struct EpiProj {
    static constexpr bool PERM = true, AFTER_DRAIN = false;
    bf16 *QB, *VB, *GB, *BB, *UB; float* LF; const float* lbl; int layer;
    __device__ __forceinline__ void operator()(const f32x4 (&acc)[2][2][4][2], const pg8::Unit& u, int wr, int wc, int fr, int fq) const {
        const int row0 = u.pm * 256 + wr * 64 + fr, cw = wc * 32 + 8 * fq;
        if (u.pn >= 10) {
            const int col = (u.pn - 10) * 128 + cw;
#pragma unroll
            for (int ai = 0; ai < 2; ++ai)
#pragma unroll
                for (int m = 0; m < 4; ++m) {
                    const f32x4 v0 = acc[ai][0][m][0] * acc[ai][1][m][0], v1 = acc[ai][0][m][1] * acc[ai][1][m][1];
                    u32x4 w; w.x = pk(v0[0], v0[1]); w.y = pk(v0[2], v0[3]); w.z = pk(v1[0], v1[1]); w.w = pk(v1[2], v1[3]);
                    *(u32x4*)(UB + (size_t)(row0 + ai * 128 + m * 16) * HW + col) = w;
                }
        } else {
            const int blk = u.pn >> 1, cb = (u.pn & 1) * 256 + cw;
            if (blk == 1) {
                f32x4 lb[2][2];
#pragma unroll
                for (int bj = 0; bj < 2; ++bj)
#pragma unroll
                    for (int n = 0; n < 2; ++n)
#pragma unroll
                        for (int e = 0; e < 4; ++e) { const int col = cb + bj * 128 + 4 * n + e; lb[bj][n][e] = (layer == 0) ? 0.f : 1.f / (1.f + __expf(lbl[col] - lbl[HW + col])); }
#pragma unroll
                for (int ai = 0; ai < 2; ++ai)
#pragma unroll
                    for (int m = 0; m < 4; ++m)
#pragma unroll
                        for (int bj = 0; bj < 2; ++bj) {
                            float* dst = LF + (size_t)(row0 + ai * 128 + m * 16) * HW + cb + bj * 128;
#pragma unroll
                            for (int n = 0; n < 2; ++n) {
                                f32x4 o;
#pragma unroll
                                for (int e = 0; e < 4; ++e) {
                                    const float z = acc[ai][bj][m][n][e], l = lb[bj][n][e];
                                    const float ls = fminf(z, 0.f) - __logf(1.f + __expf(-fabsf(z)));
                                    o[e] = (l > 0.f) ? __logf(l + (1.f - l) * __expf(ls)) : ls;
                                }
                                *(f32x4*)(dst + 4 * n) = o;
                            }
                        }
            } else {
                bf16* dst0 = (blk == 0) ? QB : (blk == 2) ? VB : (blk == 3) ? GB : BB;
                const bool act = (blk == 0) || (blk == 3);
#pragma unroll
                for (int ai = 0; ai < 2; ++ai)
#pragma unroll
                    for (int m = 0; m < 4; ++m)
#pragma unroll
                        for (int bj = 0; bj < 2; ++bj) {
                            f32x4 v0 = acc[ai][bj][m][0], v1 = acc[ai][bj][m][1];
                            if (act) {
#pragma unroll
                                for (int e = 0; e < 4; ++e) { v0[e] = silu_f(v0[e]); v1[e] = silu_f(v1[e]); }
                            }
                            u32x4 w; w.x = pk(v0[0], v0[1]); w.y = pk(v0[2], v0[3]); w.z = pk(v1[0], v1[1]); w.w = pk(v1[2], v1[3]);
                            *(u32x4*)(dst0 + (size_t)(row0 + ai * 128 + m * 16) * HW + cb + bj * 128) = w;
                        }
            }
        }
    }
};
struct EpiRes {
    static constexpr bool PERM = true, AFTER_DRAIN = false;
    const bf16* res; bf16* out;
    __device__ __forceinline__ void operator()(const f32x4 (&acc)[2][2][4][2], const pg8::Unit& u, int wr, int wc, int fr, int fq) const {
        const int row0 = u.pm * 256 + wr * 64 + fr, c0 = u.pn * 256 + wc * 32 + 8 * fq;
#pragma unroll
        for (int ai = 0; ai < 2; ++ai)
#pragma unroll
            for (int m = 0; m < 4; ++m)
#pragma unroll
                for (int bj = 0; bj < 2; ++bj) {
                    const size_t off = (size_t)(row0 + ai * 128 + m * 16) * DM + c0 + bj * 128;
                    const u32x4 r = *(const u32x4*)(res + off);
                    const f32x4 a0 = acc[ai][bj][m][0], a1 = acc[ai][bj][m][1];
                    u32x4 w;
                    w.x = pk(a0[0] + ALPHA * bflo(r.x), a0[1] + ALPHA * bfhi(r.x)); w.y = pk(a0[2] + ALPHA * bflo(r.y), a0[3] + ALPHA * bfhi(r.y));
                    w.z = pk(a1[0] + ALPHA * bflo(r.z), a1[1] + ALPHA * bfhi(r.z)); w.w = pk(a1[2] + ALPHA * bflo(r.w), a1[3] + ALPHA * bfhi(r.w));
                    *(u32x4*)(out + off) = w;
                }
    }
};
struct EpiRelu2 {
    static constexpr bool PERM = true, AFTER_DRAIN = false;
    bf16* out;
    __device__ __forceinline__ void operator()(const f32x4 (&acc)[2][2][4][2], const pg8::Unit& u, int wr, int wc, int fr, int fq) const {
        const int row0 = u.pm * 256 + wr * 64 + fr, c0 = u.pn * 256 + wc * 32 + 8 * fq;
#pragma unroll
        for (int ai = 0; ai < 2; ++ai)
#pragma unroll
            for (int m = 0; m < 4; ++m)
#pragma unroll
                for (int bj = 0; bj < 2; ++bj) {
                    f32x4 a0 = acc[ai][bj][m][0], a1 = acc[ai][bj][m][1];
#pragma unroll
                    for (int e = 0; e < 4; ++e) { const float x = fmaxf(a0[e], 0.f), y = fmaxf(a1[e], 0.f); a0[e] = x * x; a1[e] = y * y; }
                    u32x4 w; w.x = pk(a0[0], a0[1]); w.y = pk(a0[2], a0[3]); w.z = pk(a1[0], a1[1]); w.w = pk(a1[2], a1[3]);
                    *(u32x4*)(out + (size_t)(row0 + ai * 128 + m * 16) * FF + c0 + bj * 128) = w;
                }
    }
};

__device__ __forceinline__ int remap_in(int n0) {
    if (n0 < 2560) return n0;
    if (n0 < 3072) { const int c = n0 - 2560; return 2560 + 256 * (c >> 7) + (c & 127); }
    const int c = n0 - 3072; return 2560 + 256 * (c >> 7) + 128 + (c & 127);
}
__device__ __forceinline__ void transpose_item(const float* W, int K, int N, bf16* WT, bool remap, LAS float* scr, int item, int lane) {
    const int nblk = N / 32, kb = item / nblk, nb = item % nblk, k0 = 64 * kb, n0 = 32 * nb;
    const int d0 = remap ? remap_in(n0) : n0;
#pragma unroll 8
    for (int i = 0; i < 32; ++i) { const int kk = 2 * i + (lane >> 5); scr[kk * 33 + (lane & 31)] = W[(size_t)(k0 + kk) * N + n0 + (lane & 31)]; }
    asm volatile("s_waitcnt lgkmcnt(0)" ::: "memory");
    const int c = lane & 7;
#pragma unroll
    for (int j = 0; j < 4; ++j) { const int n = (lane >> 3) + 8 * j; const LAS float* s = scr + (8 * c) * 33 + n;
        u32x4 o; o.x = pk(s[0 * 33], s[1 * 33]); o.y = pk(s[2 * 33], s[3 * 33]); o.z = pk(s[4 * 33], s[5 * 33]); o.w = pk(s[6 * 33], s[7 * 33]);
        *(u32x4*)(WT + (size_t)(d0 + n) * K + k0 + 8 * c) = o; }
    asm volatile("s_waitcnt lgkmcnt(0)" ::: "memory");
}
__device__ __forceinline__ void p0_phase(ldsp lds, const float* const* in, unsigned char* ws, int gw, int ngw, int wave, int lane) {
    LAS float* scr = (LAS float*)(lds + wave * 16384);
    constexpr int I_IN = 16 * 112, I_OUT = 16 * 32, I_F1 = 16 * 128, I_F2 = 64 * 32, I_L = I_IN + I_OUT + I_F1 + I_F2;
    for (int it = gw; it < 2 * I_L; it += ngw) {
        const int l = it / I_L; int r = it % I_L;
        unsigned char* wl = ws + WS_W + (size_t)l * W_LAYER;
        if (r < I_IN) { transpose_item(in[4] + (size_t)l * DM * PW, DM, PW, (bf16*)(wl + W_IN), true, scr, r, lane); continue; } r -= I_IN;
        if (r < I_OUT) { transpose_item(in[8] + (size_t)l * DM * DM, DM, DM, (bf16*)(wl + W_OUT), false, scr, r, lane); continue; } r -= I_OUT;
        if (r < I_F1) { transpose_item(in[11] + (size_t)l * DM * FF, DM, FF, (bf16*)(wl + W_FF1), false, scr, r, lane); continue; } r -= I_F1;
        transpose_item(in[12] + (size_t)l * FF * DM, FF, DM, (bf16*)(wl + W_FF2), false, scr, r, lane);
    }
    bf16* XB = (bf16*)(ws + WS_XB);
    for (int r = gw; r < TT; r += ngw) {
        const float* src = (r < TP) ? in[0] + (size_t)r * DM : in[1] + (size_t)(r - TP) * DM;
#pragma unroll
        for (int j = 0; j < 4; ++j) { const f32x4 v = *(const f32x4*)(src + 4 * lane + 256 * j); u32x2 w; w.x = pk(v[0], v[1]); w.y = pk(v[2], v[3]); *(u32x2*)(XB + (size_t)r * DM + 4 * lane + 256 * j) = w; }
    }
}

constexpr int L_BS = 0, L_QS = 32768, L_KS = 50176, L_KT = 32768, L_VT = 67584, L_ST = 86016, L_PP = 120832, L_SEG = 130048, L_RED = 132096;
constexpr int RS128 = 272, RS64 = 144;

__device__ __forceinline__ void load_cumsum(ldsp lds, const float* LF, int tok0, int h, float (&kk)[16], int tid) {
    LAS float* BS = (LAS float*)(lds + L_BS); LAS float* SEG = (LAS float*)(lds + L_SEG);
#pragma unroll
    for (int j = 0; j < 4; ++j) { const int idx = tid + 512 * j, t = idx >> 5, c4 = idx & 31;
        *(LAS f32x4*)(BS + t * 128 + 4 * c4) = *(const f32x4*)(LF + (size_t)(tok0 + t) * HW + h * 128 + 4 * c4); }
    __syncthreads();
    const int c = tid & 127, sg = tid >> 7;
    float run = 0.f;
#pragma unroll
    for (int i = 0; i < 16; ++i) { const int t = sg * 16 + i; const float lf = BS[t * 128 + c]; kk[i] = -expm1f(lf); run += lf; BS[t * 128 + c] = run; }
    SEG[sg * 128 + c] = run;
    __syncthreads();
    float off = 0.f;
    for (int s = 0; s < sg; ++s) off += SEG[s * 128 + c];
#pragma unroll
    for (int i = 0; i < 16; ++i) BS[(sg * 16 + i) * 128 + c] += off;
    __syncthreads();
}
__device__ __forceinline__ void load_vt(ldsp lds, const bf16* VB, int tok0, int h, int tid) {
    const int c2 = tid & 63, sgp = tid >> 6;
    unsigned w[8];
#pragma unroll
    for (int e = 0; e < 8; ++e) w[e] = *(const unsigned*)(VB + (size_t)(tok0 + 8 * sgp + e) * HW + h * 128 + 2 * c2);
    u32x4 lo, hi;
    lo.x = (w[0] & 0xffffu) | (w[1] << 16); lo.y = (w[2] & 0xffffu) | (w[3] << 16); lo.z = (w[4] & 0xffffu) | (w[5] << 16); lo.w = (w[6] & 0xffffu) | (w[7] << 16);
    hi.x = (w[0] >> 16) | (w[1] & 0xffff0000u); hi.y = (w[2] >> 16) | (w[3] & 0xffff0000u); hi.z = (w[4] >> 16) | (w[5] & 0xffff0000u); hi.w = (w[6] >> 16) | (w[7] & 0xffff0000u);
    *(LAS u32x4*)(lds + L_VT + (2 * c2) * RS64 + 16 * sgp) = lo;
    *(LAS u32x4*)(lds + L_VT + (2 * c2 + 1) * RS64 + 16 * sgp) = hi;
}

__device__ __forceinline__ void h1_prompt_unit(ldsp lds, int unit, const float* LF, const bf16* VB, float* Lbuf, float* DEC, int tid, int wave, int lane) {
    const int bh = unit >> 5, n = unit & 31, b = bh >> 2, h = bh & 3, tok0 = b * SEQ + n * 64;
    float kk[16];
    load_cumsum(lds, LF, tok0, h, kk, tid);
    LAS float* BS = (LAS float*)(lds + L_BS);
    const int c = tid & 127, sg = tid >> 7;
    const float blast = BS[63 * 128 + c];
#pragma unroll
    for (int hf = 0; hf < 2; ++hf) {
        float kd[8];
#pragma unroll
        for (int e = 0; e < 8; ++e) { const int i = hf * 8 + e; kd[e] = kk[i] * __expf(blast - BS[(sg * 16 + i) * 128 + c]); }
        u32x4 w; w.x = pk(kd[0], kd[1]); w.y = pk(kd[2], kd[3]); w.z = pk(kd[4], kd[5]); w.w = pk(kd[6], kd[7]);
        *(LAS u32x4*)(lds + L_KT + c * RS64 + (sg * 16 + hf * 8) * 2) = w;
    }
    if (sg == 0) DEC[unit * 128 + c] = __expf(blast);
    load_vt(lds, VB, tok0, h, tid);
    __syncthreads();
    const int fr = lane & 15, fq = lane >> 4;
    bf16x8 bk[2];
#pragma unroll
    for (int k2 = 0; k2 < 2; ++k2) bk[k2] = *(const LAS bf16x8*)(lds + L_KT + (16 * wave + fr) * RS64 + (32 * k2 + 8 * fq) * 2);
    float* Lu = Lbuf + (size_t)unit * 16384;
#pragma unroll
    for (int mt = 0; mt < 8; ++mt) {
        f32x4 acc = {0.f, 0.f, 0.f, 0.f};
#pragma unroll
        for (int k2 = 0; k2 < 2; ++k2) { const bf16x8 a = *(const LAS bf16x8*)(lds + L_VT + (16 * mt + fr) * RS64 + (32 * k2 + 8 * fq) * 2); acc = MFMA16(a, bk[k2], acc); }
        *(f32x4*)(Lu + (16 * wave + fr) * 128 + 16 * mt + 4 * fq) = acc;
    }
}

__device__ __forceinline__ void h_sample_unit(ldsp lds, int su, int layer, const float* LF, const bf16* QB, const bf16* VB, const bf16* GB, const float* state_hgrn, const float* onorm,
                                              bf16* MIX, float* out, int tid, int wave, int lane) {
    const int b = su >> 2, h = su & 3, R0 = TP + b * 8;
    LAS float* bs = (LAS float*)(lds + 0); LAS float* kkS = (LAS float*)(lds + 4096); LAS float* qq = (LAS float*)(lds + 8192); LAS float* aq = (LAS float*)(lds + 12288);
    LAS float* kd = (LAS float*)(lds + 16384); LAS float* vv = (LAS float*)(lds + 20480); LAS float* sc = (LAS float*)(lds + 24576); LAS float* part = (LAS float*)(lds + 32768);
    {
        const int c = tid & 127, p = tid >> 7;
        if (p == 0) {
            float run = 0.f;
#pragma unroll
            for (int t = 0; t < 8; ++t) { const float lf = LF[(size_t)(R0 + t) * HW + h * 128 + c]; kkS[t * 128 + c] = -expm1f(lf); run += lf; bs[t * 128 + c] = run; }
#pragma unroll
            for (int t = 0; t < 8; ++t) { const float bt = bs[t * 128 + c]; const float q = bf1(QB[(size_t)(R0 + t) * HW + h * 128 + c]);
                qq[t * 128 + c] = q; aq[t * 128 + c] = q * __expf(bt); kd[t * 128 + c] = kkS[t * 128 + c] * __expf(run - bt); }
        } else if (p == 1) {
#pragma unroll
            for (int t = 0; t < 8; ++t) vv[t * 128 + c] = bf1(VB[(size_t)(R0 + t) * HW + h * 128 + c]);
        }
    }
    __syncthreads();
    {
        const int pair = tid >> 3, t = pair >> 3, s = pair & 7, sub = tid & 7;
        float sum = 0.f;
        if (s <= t) {
#pragma unroll
            for (int e = 0; e < 16; ++e) { const int c = sub * 16 + e; sum += qq[t * 128 + c] * __expf(bs[t * 128 + c] - bs[s * 128 + c]) * kkS[s * 128 + c]; }
        }
        sum += __shfl_xor(sum, 1); sum += __shfl_xor(sum, 2); sum += __shfl_xor(sum, 4);
        if (sub == 0) sc[t * 8 + s] = sum;
    }
    __syncthreads();
    {
        const int v4 = tid & 31, kg = tid >> 5;
        const size_t so = (((size_t)layer * 128 + b) * 4 + h) * 16384;
        const float* S0 = state_hgrn + so; float* SN = out + O_HS + so;
        f32x4 op[8];
#pragma unroll
        for (int t = 0; t < 8; ++t) op[t] = (f32x4){0.f, 0.f, 0.f, 0.f};
#pragma unroll
        for (int i = 0; i < 8; ++i) {
            const int k = 8 * kg + i;
            const f32x4 s0 = *(const f32x4*)(S0 + k * 128 + 4 * v4);
#pragma unroll
            for (int t = 0; t < 8; ++t) op[t] += aq[t * 128 + k] * s0;
            f32x4 sn = s0 * __expf(bs[7 * 128 + k]);
#pragma unroll
            for (int s = 0; s < 8; ++s) sn += kd[s * 128 + k] * (*(const LAS f32x4*)(vv + s * 128 + 4 * v4));
            *(f32x4*)(SN + k * 128 + 4 * v4) = sn;
        }
#pragma unroll
        for (int t = 0; t < 8; ++t) {
#pragma unroll
            for (int e = 0; e < 4; ++e) op[t][e] += __shfl_xor(op[t][e], 32);
            if (lane < 32) *(LAS f32x4*)(part + (wave * 8 + t) * 128 + 4 * v4) = op[t];
        }
    }
    __syncthreads();
    {
        const int t = wave, v = 2 * lane;
        float o0 = 0.f, o1 = 0.f;
#pragma unroll
        for (int w = 0; w < 8; ++w) { o0 += part[(w * 8 + t) * 128 + v]; o1 += part[(w * 8 + t) * 128 + v + 1]; }
        for (int s = 0; s <= t; ++s) { const float p = sc[t * 8 + s]; o0 += p * vv[s * 128 + v]; o1 += p * vv[s * 128 + v + 1]; }
        const float rstd = rsqrtf(wave_sum(o0 * o0 + o1 * o1) * (1.f / 128.f) + RMS_EPS);
        const unsigned g = *(const unsigned*)(GB + (size_t)(R0 + t) * HW + h * 128 + v);
        const float on0 = onorm[layer * HW + h * 128 + v], on1 = onorm[layer * HW + h * 128 + v + 1];
        *(unsigned*)(MIX + (size_t)(R0 + t) * DM + h * 128 + v) = pk(o0 * rstd * on0 * bflo(g), o1 * rstd * on1 * bfhi(g));
    }
}

__device__ __forceinline__ void h3_prompt_unit(ldsp lds, int unit, int layer, const float* LF, const bf16* QB, const bf16* VB, const bf16* GB, const float* Sbuf, const float* onorm,
                                               bf16* MIX, int tid, int wave, int lane) {
    const int bh = unit >> 5, n = unit & 31, b = bh >> 2, h = bh & 3, tok0 = b * SEQ + n * 64;
    float kk[16];
    load_cumsum(lds, LF, tok0, h, kk, tid);
    LAS float* BS = (LAS float*)(lds + L_BS);
    {
        const int c = tid & 127, sg = tid >> 7;
        const float bref = BS[31 * 128 + c];
#pragma unroll
        for (int i = 0; i < 16; ++i) {
            const int t = sg * 16 + i; const float bt = BS[t * 128 + c];
            const float q = bf1(QB[(size_t)(tok0 + t) * HW + h * 128 + c]);
            *(LAS bf16*)(lds + L_QS + t * RS128 + 2 * c) = tobf(q * __expf(fminf(bt - bref, 80.f)));
            *(LAS bf16*)(lds + L_KS + t * RS128 + 2 * c) = tobf(kk[i] * __expf(fminf(bref - bt, 80.f)));
        }
    }
    load_vt(lds, VB, tok0, h, tid);
    {
        const int v = tid & 127, kg = tid >> 7;
        const float* Su = Sbuf + (size_t)unit * 16384;
#pragma unroll
        for (int i8 = 0; i8 < 4; ++i8) {
            const int k0 = 32 * kg + 8 * i8;
            float s[8];
#pragma unroll
            for (int e = 0; e < 8; ++e) s[e] = Su[(k0 + e) * 128 + v] * __expf(BS[31 * 128 + k0 + e]);
            u32x4 w; w.x = pk(s[0], s[1]); w.y = pk(s[2], s[3]); w.z = pk(s[4], s[5]); w.w = pk(s[6], s[7]);
            *(LAS u32x4*)(lds + L_ST + v * RS128 + k0 * 2) = w;
        }
    }
    __syncthreads();
    const int fr = lane & 15, fq = lane >> 4, tm = wave >> 1;
    {
        const int ts0 = (wave & 1) * 2;
        f32x4 sc[2] = {{0.f, 0.f, 0.f, 0.f}, {0.f, 0.f, 0.f, 0.f}};
#pragma unroll
        for (int k2 = 0; k2 < 4; ++k2) {
            const bf16x8 a = *(const LAS bf16x8*)(lds + L_QS + (16 * tm + fr) * RS128 + (32 * k2 + 8 * fq) * 2);
#pragma unroll
            for (int i = 0; i < 2; ++i) { const bf16x8 bb = *(const LAS bf16x8*)(lds + L_KS + (16 * (ts0 + i) + fr) * RS128 + (32 * k2 + 8 * fq) * 2); sc[i] = MFMA16(a, bb, sc[i]); }
        }
#pragma unroll
        for (int i = 0; i < 2; ++i)
#pragma unroll
            for (int j = 0; j < 4; ++j) { const int t = 16 * tm + 4 * fq + j, s = 16 * (ts0 + i) + fr;
                *(LAS bf16*)(lds + L_PP + t * RS64 + 2 * s) = tobf((s <= t) ? sc[i][j] : 0.f); }
    }
    __syncthreads();
    const int vh = wave & 1;
    f32x4 o[4];
#pragma unroll
    for (int i = 0; i < 4; ++i) o[i] = (f32x4){0.f, 0.f, 0.f, 0.f};
#pragma unroll
    for (int k2 = 0; k2 < 4; ++k2) {
        const bf16x8 bq = *(const LAS bf16x8*)(lds + L_QS + (16 * tm + fr) * RS128 + (32 * k2 + 8 * fq) * 2);
#pragma unroll
        for (int i = 0; i < 4; ++i) { const bf16x8 a = *(const LAS bf16x8*)(lds + L_ST + (16 * (4 * vh + i) + fr) * RS128 + (32 * k2 + 8 * fq) * 2); o[i] = MFMA16(a, bq, o[i]); }
    }
#pragma unroll
    for (int k2 = 0; k2 < 2; ++k2) {
        const bf16x8 bp = *(const LAS bf16x8*)(lds + L_PP + (16 * tm + fr) * RS64 + (32 * k2 + 8 * fq) * 2);
#pragma unroll
        for (int i = 0; i < 4; ++i) { const bf16x8 a = *(const LAS bf16x8*)(lds + L_VT + (16 * (4 * vh + i) + fr) * RS64 + (32 * k2 + 8 * fq) * 2); o[i] = MFMA16(a, bp, o[i]); }
    }
    float ss = 0.f;
#pragma unroll
    for (int i = 0; i < 4; ++i) ss += (o[i][0] * o[i][0] + o[i][1] * o[i][1]) + (o[i][2] * o[i][2] + o[i][3] * o[i][3]);
    ss += __shfl_xor(ss, 16); ss += __shfl_xor(ss, 32);
    LAS float* RED = (LAS float*)(lds + L_RED);
    if (fq == 0) RED[vh * 64 + 16 * tm + fr] = ss;
    __syncthreads();
    const float rstd = rsqrtf((RED[16 * tm + fr] + RED[64 + 16 * tm + fr]) * (1.f / 128.f) + RMS_EPS);
    const size_t row = (size_t)(tok0 + 16 * tm + fr);
#pragma unroll
    for (int i = 0; i < 4; ++i) {
        const int vc = h * 128 + 16 * (4 * vh + i) + 4 * fq;
        const u32x2 g = *(const u32x2*)(GB + row * HW + vc);
        const f32x4 on = *(const f32x4*)(onorm + layer * HW + vc);
        u32x2 w; w.x = pk(o[i][0] * rstd * on[0] * bflo(g.x), o[i][1] * rstd * on[1] * bfhi(g.x)); w.y = pk(o[i][2] * rstd * on[2] * bflo(g.y), o[i][3] * rstd * on[3] * bfhi(g.y));
        *(u32x2*)(MIX + row * DM + vc) = w;
    }
}

__device__ __forceinline__ void h2_phase(int layer, float* Lbuf, const float* DEC, float* out, const bf16* UB, const bf16* BB, const float* state_conv, const float* conv_w, bf16* MIX, int gtid, int ngt) {
    for (int g = gtid; g < 32 * 4096; g += ngt) {
        const int bh = g >> 12, k = (g >> 5) & 127, v4 = g & 31;
        f32x4 S = {0.f, 0.f, 0.f, 0.f};
        float* Lp = Lbuf + (size_t)bh * 32 * 16384 + k * 128 + 4 * v4;
        const float* dp = DEC + bh * 32 * 128 + k;
#pragma unroll 8
        for (int n = 0; n < NCHUNK; ++n) { const f32x4 l = *(const f32x4*)(Lp + (size_t)n * 16384); const float d = dp[n * 128]; *(f32x4*)(Lp + (size_t)n * 16384) = S; S = S * d + l; }
        *(f32x4*)(out + O_HP + ((size_t)layer * 32 + bh) * 16384 + k * 128 + 4 * v4) = S;
    }
    for (int g = gtid; g < TT * 64; g += ngt) {
        const int r = g >> 6, c = (g & 63) * 8;
        int t, bsm = -1, row0;
        if (r < TP) { t = r & (SEQ - 1); row0 = r - t; } else { const int q = r - TP; t = q & 7; bsm = q >> 3; row0 = r - t; }
        float u0[8], u1[8], u2[8];
        { const u32x4 w = *(const u32x4*)(UB + (size_t)r * HW + c); u2[0] = bflo(w.x); u2[1] = bfhi(w.x); u2[2] = bflo(w.y); u2[3] = bfhi(w.y); u2[4] = bflo(w.z); u2[5] = bfhi(w.z); u2[6] = bflo(w.w); u2[7] = bfhi(w.w); }
        if (t >= 1) { const u32x4 w = *(const u32x4*)(UB + (size_t)(r - 1) * HW + c); u1[0] = bflo(w.x); u1[1] = bfhi(w.x); u1[2] = bflo(w.y); u1[3] = bfhi(w.y); u1[4] = bflo(w.z); u1[5] = bfhi(w.z); u1[6] = bflo(w.w); u1[7] = bfhi(w.w); }
        else {
#pragma unroll
            for (int e = 0; e < 8; ++e) u1[e] = (bsm >= 0) ? state_conv[(((size_t)layer * 128 + bsm) * 2 + 1) * HW + c + e] : 0.f;
        }
        if (t >= 2) { const u32x4 w = *(const u32x4*)(UB + (size_t)(r - 2) * HW + c); u0[0] = bflo(w.x); u0[1] = bfhi(w.x); u0[2] = bflo(w.y); u0[3] = bfhi(w.y); u0[4] = bflo(w.z); u0[5] = bfhi(w.z); u0[6] = bflo(w.w); u0[7] = bfhi(w.w); }
        else {
#pragma unroll
            for (int e = 0; e < 8; ++e) u0[e] = (bsm >= 0) ? state_conv[(((size_t)layer * 128 + bsm) * 2 + t) * HW + c + e] : 0.f;
        }
        const u32x4 gb = *(const u32x4*)(BB + (size_t)r * HW + c);
        float gv[8] = {bflo(gb.x), bfhi(gb.x), bflo(gb.y), bfhi(gb.y), bflo(gb.z), bfhi(gb.z), bflo(gb.w), bfhi(gb.w)};
        float y[8];
#pragma unroll
        for (int e = 0; e < 8; ++e) { const float w0 = conv_w[(layer * 3 + 0) * HW + c + e], w1 = conv_w[(layer * 3 + 1) * HW + c + e], w2 = conv_w[(layer * 3 + 2) * HW + c + e];
            y[e] = gv[e] * (w0 * u0[e] + w1 * u1[e] + w2 * u2[e]); }
        u32x4 w; w.x = pk(y[0], y[1]); w.y = pk(y[2], y[3]); w.z = pk(y[4], y[5]); w.w = pk(y[6], y[7]);
        *(u32x4*)(MIX + (size_t)r * DM + HW + c) = w;
        (void)row0;
        if (bsm < 0) { if (t >= SEQ - 2) { float* d = out + O_CP + (((size_t)layer * 8 + (r >> 11)) * 2 + (t - (SEQ - 2))) * HW + c;
#pragma unroll
                for (int e = 0; e < 8; ++e) d[e] = u2[e]; } }
        else { if (t >= 6) { float* d = out + O_CS + (((size_t)layer * 128 + bsm) * 2 + (t - 6)) * HW + c;
#pragma unroll
                for (int e = 0; e < 8; ++e) d[e] = u2[e]; } }
    }
}

__device__ __forceinline__ void ln_phase(bf16* X, const float* g, const float* bta, float* yout, int gw, int ngw, int lane) {
    for (int r = gw; r < TT; r += ngw) {
        bf16* xr = X + (size_t)r * DM;
        const u32x4 a0 = *(const u32x4*)(xr + 8 * lane), a1 = *(const u32x4*)(xr + 512 + 8 * lane);
        float v[16] = {bflo(a0.x), bfhi(a0.x), bflo(a0.y), bfhi(a0.y), bflo(a0.z), bfhi(a0.z), bflo(a0.w), bfhi(a0.w),
                       bflo(a1.x), bfhi(a1.x), bflo(a1.y), bfhi(a1.y), bflo(a1.z), bfhi(a1.z), bflo(a1.w), bfhi(a1.w)};
        float s = 0.f;
#pragma unroll
        for (int e = 0; e < 16; ++e) s += v[e];
        const float mean = wave_sum(s) * (1.f / DM);
        float s2 = 0.f;
#pragma unroll
        for (int e = 0; e < 16; ++e) { v[e] -= mean; s2 += v[e] * v[e]; }
        const float rstd = rsqrtf(wave_sum(s2) * (1.f / DM) + LN_EPS);
#pragma unroll
        for (int hf = 0; hf < 2; ++hf) {
            const int c = hf * 512 + 8 * lane;
            const f32x4 g0 = *(const f32x4*)(g + c), g1 = *(const f32x4*)(g + c + 4), b0 = *(const f32x4*)(bta + c), b1 = *(const f32x4*)(bta + c + 4);
            f32x4 y0, y1;
#pragma unroll
            for (int e = 0; e < 4; ++e) { y0[e] = v[hf * 8 + e] * rstd * g0[e] + b0[e]; y1[e] = v[hf * 8 + 4 + e] * rstd * g1[e] + b1[e]; }
            u32x4 w; w.x = pk(y0[0], y0[1]); w.y = pk(y0[2], y0[3]); w.z = pk(y1[0], y1[1]); w.w = pk(y1[2], y1[3]);
            *(u32x4*)(xr + c) = w;
            if (yout) { *(f32x4*)(yout + (size_t)r * DM + c) = y0; *(f32x4*)(yout + (size_t)r * DM + c + 4) = y1; }
        }
    }
}

struct Args { const float* in[15]; float* out; unsigned char* ws; int ph_lo, ph_hi; };
__global__ void __launch_bounds__(512, 2) mk_fwd(Args a) {
    extern __shared__ __attribute__((aligned(16))) unsigned char lds_raw[];
    ldsp lds = (ldsp)lds_raw;
    cg::grid_group grid = cg::this_grid();
    const int G = gridDim.x, bx = blockIdx.x;
    for (int ph = a.ph_lo; ph < a.ph_hi; ++ph) {
        int tid = threadIdx.x; asm volatile("" : "+v"(tid));
        unsigned char* ws = a.ws; asm volatile("" : "+s"(ws));
        float* out = a.out; asm volatile("" : "+s"(out));
        const int lane = tid & 63, wave = __builtin_amdgcn_readfirstlane(tid >> 6);
        const int gw = bx * 8 + wave, ngw = G * 8;
        bf16* XB = (bf16*)(ws + WS_XB); bf16* MIX = (bf16*)(ws + WS_MIX); bf16* X1 = (bf16*)out; float* Lbuf = out; float* DEC = (float*)(ws + WS_DEC);
        bf16* QB = (bf16*)(ws + WS_QB); float* LF = (float*)(ws + WS_LF); bf16* VB = (bf16*)(ws + WS_VB); bf16* GB = (bf16*)(ws + WS_GB); bf16* BB = (bf16*)(ws + WS_BB); bf16* UB = (bf16*)(ws + WS_UB);
        bf16* HID = (bf16*)(ws + WS_HID);
        if (ph == 0 && (PHMASK & 512)) {
            p0_phase(lds, a.in, ws, gw, ngw, wave, lane);
        } else {
            const int layer = (ph - 1) / 9, kind = (ph - 1) % 9;
            const unsigned char* wl = ws + WS_W + (size_t)layer * W_LAYER;
            if (kind == 0 && (PHMASK & 1)) {
                pg8::Gemm g{(const bf16*)XB, (const bf16*)(wl + W_IN), TT, PW, DM}; pg8::StaticOrder S; S.init(TT, PW, G, bx);
                EpiProj E{QB, VB, GB, BB, UB, LF, a.in[5], layer};
                pg8::gemm_phase<EpiProj, pg8::StaticOrder, true, true>(lds, g, S, E);
            } else if (kind == 1 && (PHMASK & 2)) {
                for (int u = bx; u < NPU + NSU; u += G) {
                    __syncthreads();
                    if (u < NPU) h1_prompt_unit(lds, u, LF, VB, Lbuf, DEC, tid, wave, lane);
                    else h_sample_unit(lds, u - NPU, layer, LF, QB, VB, GB, a.in[2], a.in[7], MIX, out, tid, wave, lane);
                }
            } else if (kind == 2 && (PHMASK & 4)) {
                h2_phase(layer, Lbuf, DEC, out, UB, BB, a.in[3], a.in[6], MIX, bx * 512 + tid, G * 512);
            } else if (kind == 3 && (PHMASK & 8)) {
                for (int u = bx; u < NPU; u += G) { __syncthreads(); h3_prompt_unit(lds, u, layer, LF, QB, VB, GB, Lbuf, a.in[7], MIX, tid, wave, lane); }
            } else if ((kind == 4 || kind == 7) && (PHMASK & 16)) {
                const bool second = (kind == 7);
                pg8::Gemm g{second ? (const bf16*)HID : (const bf16*)MIX, (const bf16*)(wl + (second ? W_FF2 : W_OUT)), TT, DM, second ? FF : DM}; pg8::StaticOrder S; S.init(TT, DM, G, bx);
                EpiRes E{second ? (const bf16*)X1 : (const bf16*)XB, second ? XB : X1};
                pg8::gemm_phase<EpiRes, pg8::StaticOrder, true, true>(lds, g, S, E);
            } else if (kind == 5 && (PHMASK & 32)) {
                ln_phase(X1, a.in[9] + layer * DM, a.in[10] + layer * DM, nullptr, gw, ngw, lane);
            } else if (kind == 6 && (PHMASK & 64)) {
                pg8::Gemm g{(const bf16*)X1, (const bf16*)(wl + W_FF1), TT, FF, DM}; pg8::StaticOrder S; S.init(TT, FF, G, bx);
                EpiRelu2 E{HID};
                pg8::gemm_phase<EpiRelu2, pg8::StaticOrder, true, true>(lds, g, S, E);
            } else if (PHMASK & 256) {
                ln_phase(XB, a.in[13] + layer * DM, a.in[14] + layer * DM, (layer == 1) ? out + O_Y : nullptr, gw, ngw, lane);
            }
        }
        if (ph + 1 < a.ph_hi) grid.sync();
    }
}

extern "C" void kernel_launch(void* const* d_in, const int* in_sizes, int n_in, void* d_out, int out_size, void* d_ws, size_t ws_size, hipStream_t stream) {
    static int grid = 0;
    if (grid == 0) {
        if (n_in != 15 || in_sizes[0] != TP * DM || (size_t)out_size != O_END || ws_size < WS_END) {
            fprintf(stderr, "kernel_launch: unexpected shapes (n_in %d in0 %d out %d ws %zu); nothing launched\n", n_in, n_in > 0 ? in_sizes[0] : -1, out_size, ws_size); grid = -1; return; }
        int dev = 0, cus = 0, per_cu = 0;
        (void)hipGetDevice(&dev); (void)hipDeviceGetAttribute(&cus, hipDeviceAttributeMultiprocessorCount, dev);
        if (hipFuncSetAttribute((const void*)mk_fwd, hipFuncAttributeMaxDynamicSharedMemorySize, LDS_BYTES) != hipSuccess) { fprintf(stderr, "kernel_launch: hipFuncSetAttribute failed\n"); grid = -1; return; }
        if (hipOccupancyMaxActiveBlocksPerMultiprocessor(&per_cu, (const void*)mk_fwd, 512, LDS_BYTES) != hipSuccess || per_cu < 1) { fprintf(stderr, "kernel_launch: occupancy query says %d\n", per_cu); per_cu = 1; }
        (void)hipGetLastError();
        grid = cus > 0 ? cus : 256;
    }
    if (grid < 0) return;
    Args a{};
    for (int i = 0; i < 15; ++i) a.in[i] = (const float*)d_in[i];
    a.out = (float*)d_out; a.ws = (unsigned char*)d_ws;
    const int per = (NPHASE + MK_N_LAUNCHES - 1) / MK_N_LAUNCHES;
    for (int lo = 0; lo < NPHASE; lo += per) {
        a.ph_lo = lo; a.ph_hi = (lo + per < NPHASE) ? lo + per : NPHASE;
        void* args[] = {&a};
        const hipError_t e = hipLaunchCooperativeKernel((const void*)mk_fwd, dim3(grid), dim3(512), args, LDS_BYTES, stream);
        if (e != hipSuccess) { fprintf(stderr, "kernel_launch: cooperative launch failed: %s (grid %d)\n", hipGetErrorString(e), grid); break; }
    }
}
```

```cpp
#include <hip/hip_runtime.h>
#include <hip/hip_cooperative_groups.h>
#include <cstdio>
#include <cstdint>
namespace cg = cooperative_groups;
#define MK_N_LAUNCHES 1
#define REPMASK 0
namespace pg8 {
#define PG8_LAS __attribute__((address_space(3)))
typedef unsigned short bf16_t;
typedef short bf16x8 __attribute__((ext_vector_type(8)));
typedef float f32x4 __attribute__((ext_vector_type(4)));
typedef unsigned u32x4 __attribute__((ext_vector_type(4)));
constexpr int BM = 256, BK = 64, HALF = 128, HTB = HALF * BK * 2  , STAGE_BYTES = 8 * HTB, NXCD = 8, WGM = 8;

__host__ __device__ __forceinline__ int lds_byte(int r, int c) { const int st = (r >> 4) * 2 + (c >> 5), rr = r & 15, cc = c & 31, ob = rr * 64 + cc * 2; return st * 1024 + (ob ^ (((ob >> 9) & 1) << 5)); }
__host__ __device__ __forceinline__ void stage_rc(int b, int& R, int& C) { const int st = b / 1024, sb = b % 1024, swz = sb ^ (((sb >> 9) & 1) << 5); R = (st >> 1) * 16 + swz / 64; C = (st & 1) * 32 + (swz % 64) / 2; }
__host__ __device__ __forceinline__ int perm32(int rho) { const int n = rho >> 4, i = rho & 15; return 8 * (i >> 2) + 4 * n + (i & 3); }

struct Unit { int pm, pn; };
struct Gemm { const bf16_t* A; const bf16_t* Bt; int M, N, K; };

struct StaticOrder {
    int nM, nN, nwg, G, c;
    __host__ __device__ void init(int M, int N, int G_, int c_) { nM = M / BM; nN = N / BM; nwg = nM * nN; G = G_; c = c_; }
    __host__ __device__ bool next(int i, Unit& u) const {
        const long L = (long)i * G + c; if (L >= nwg) return false;
        int wgid = (int)L; { const int q = nwg / NXCD, r = nwg % NXCD, xcd = wgid % NXCD, off = wgid / NXCD; wgid = (xcd < r ? xcd * (q + 1) : r * (q + 1) + (xcd - r) * q) + off; }
        const int nig = WGM * nN, gid = wgid / nig, fm = gid * WGM, gsz = (nM - fm) < WGM ? (nM - fm) : WGM;
        u.pm = fm + ((wgid % nig) % gsz); u.pn = (wgid % nig) / gsz; return true;
    }
    __device__ __forceinline__ void a_ready(const Unit&) const {}
    __device__ __forceinline__ void done(const Unit&) const {}
};

__device__ __forceinline__ unsigned cvt_pk_bf16(float lo, float hi) { unsigned r; asm volatile("v_cvt_pk_bf16_f32 %0, %1, %2" : "=v"(r) : "v"(lo), "v"(hi)); return r; }
template <class Epi, class Sched, bool ALIGN_EPI = false, bool SP2 = false>
__device__ __forceinline__ void gemm_phase(PG8_LAS unsigned char* lds, const Gemm g, const Sched& S, const Epi& E) {
    int tid_ = threadIdx.x; asm volatile("" : "+v"(tid_));
    const int tid = tid_, wid = __builtin_amdgcn_readfirstlane(tid >> 6), lane = tid & 63, wr = wid >> 2, wc = wid & 3, fr = lane & 15, fq = lane >> 4;
    const int K = g.K, nt = K / BK;
    unsigned voffA[2], voffB[2];
#pragma unroll
    for (int i = 0; i < 2; ++i) { int R, C; stage_rc(tid * 16 + i * 8192, R, C); const int Rb = Epi::PERM ? ((R & ~31) + perm32(R & 31)) : R;
        voffA[i] = (unsigned)(R * K + C) * 2u; voffB[i] = (unsigned)(Rb * K + C) * 2u; }
    const size_t kstep = (size_t)(BK * 2);
    const size_t hstep = (size_t)HALF * K * 2;
    const size_t tstep = 2 * hstep;
    const unsigned ldsw = (unsigned)wid * 1024u;
    const int aoff = lds_byte(wr * 64 + fr, fq * 8), boff = lds_byte(wc * 32 + fr, fq * 8);
#define PG8_SA(b, h) (((b) * 2 + (h)) * HTB)
#define PG8_SB(b, h) ((4 + (b) * 2 + (h)) * HTB)
#define PG8_STAGE(bufoff, gbase, voff) do { _Pragma("unroll") for (int _i = 0; _i < 2; ++_i) \
        __builtin_amdgcn_global_load_lds((const unsigned*)((const char*)(gbase) + (voff)[_i]), (PG8_LAS unsigned*)(lds + (bufoff) + ldsw + _i * 8192), 16, 0, 0); } while (0)
#define PG8_LDA(dst, b, h) do { _Pragma("unroll") for (int m = 0; m < 4; ++m) _Pragma("unroll") for (int k = 0; k < 2; ++k) dst[m][k] = *(const PG8_LAS bf16x8*)(lds + PG8_SA(b, h) + aoff + m * 2048 + k * 1024); } while (0)
#define PG8_LDB(dst, b, h) do { _Pragma("unroll") for (int n = 0; n < 2; ++n) _Pragma("unroll") for (int k = 0; k < 2; ++k) dst[n][k] = *(const PG8_LAS bf16x8*)(lds + PG8_SB(b, h) + boff + n * 2048 + k * 1024); } while (0)
#define PG8_MMA(ai, bj, At, Bt) do { __builtin_amdgcn_s_setprio(1); _Pragma("unroll") for (int m = 0; m < 4; ++m) _Pragma("unroll") for (int n = 0; n < 2; ++n) _Pragma("unroll") for (int k = 0; k < 2; ++k) \
        acc[ai][bj][m][n] = __builtin_amdgcn_mfma_f32_16x16x32_bf16(Bt[n][k], At[m][k], acc[ai][bj][m][n], 0, 0, 0); __builtin_amdgcn_s_setprio(0); } while (0)
#define PG8_WAIT_V(n) asm volatile("s_waitcnt vmcnt(" #n ")" ::: "memory")
#define PG8_WAIT_L(n) asm volatile("s_waitcnt lgkmcnt(" #n ")" ::: "memory")
#define PG8_BAR __builtin_amdgcn_s_barrier()
#define PG8_SCHED __builtin_amdgcn_sched_barrier(0)
    Unit cur, nxt; int ui = 0;
    if (!S.next(0, cur)) return;
    f32x4 acc[2][2][4][2];
#pragma unroll
    for (int a = 0; a < 2; ++a)
#pragma unroll
        for (int b = 0; b < 2; ++b)
#pragma unroll
            for (int m = 0; m < 4; ++m)
#pragma unroll
                for (int n = 0; n < 2; ++n) acc[a][b][m][n] = (f32x4){0.f, 0.f, 0.f, 0.f};
    bf16x8 At[4][2], B0[2][2], B1[2][2];
    const char* cA = (const char*)g.A + (size_t)cur.pm * tstep; const char* cB = (const char*)g.Bt + (size_t)cur.pn * tstep;
    S.a_ready(cur);
    if constexpr (SP2) {
        PG8_STAGE(PG8_SB(0, 0), cB, voffB); PG8_STAGE(PG8_SB(0, 1), cB + hstep, voffB); PG8_STAGE(PG8_SA(0, 0), cA, voffA); PG8_STAGE(PG8_SA(0, 1), cA + hstep, voffA);
        if (wr == 1) PG8_BAR;
        PG8_WAIT_V(2); PG8_BAR;
        PG8_STAGE(PG8_SB(1, 0), cB + kstep, voffB); PG8_STAGE(PG8_SA(1, 0), cA + kstep, voffA); PG8_STAGE(PG8_SB(1, 1), cB + hstep + kstep, voffB);
        PG8_WAIT_V(6); PG8_BAR;
    } else {
        PG8_STAGE(PG8_SB(0, 0), cB, voffB); PG8_STAGE(PG8_SA(0, 0), cA, voffA); PG8_STAGE(PG8_SB(0, 1), cB + hstep, voffB); PG8_STAGE(PG8_SA(0, 1), cA + hstep, voffA);
        if (wr == 1) PG8_BAR;
        PG8_WAIT_V(4); PG8_BAR;
        PG8_STAGE(PG8_SB(1, 0), cB + kstep, voffB); PG8_STAGE(PG8_SA(1, 0), cA + kstep, voffA); PG8_STAGE(PG8_SB(1, 1), cB + hstep + kstep, voffB);
        PG8_WAIT_V(6); PG8_BAR;
    }
    for (;;) {
        const bool has_next = S.next(ui + 1, nxt);
        const char* nA = has_next ? (const char*)g.A + (size_t)nxt.pm * tstep : cA; const char* nB = has_next ? (const char*)g.Bt + (size_t)nxt.pn * tstep : cB;
        for (int t = 0; t < nt; t += 2) {
            const bool last = (t == nt - 2);
            const char* a1 = cA + (size_t)(t + 1) * kstep;
            const char* a2 = last ? nA : cA + (size_t)(t + 2) * kstep; const char* b2 = last ? nB : cB + (size_t)(t + 2) * kstep;
            const char* a3 = a2 + kstep; const char* b3 = b2 + kstep;
            if (last && has_next) S.a_ready(nxt);
            if constexpr (SP2) {
            PG8_LDB(B0, 0, 0); PG8_LDB(B1, 0, 1); PG8_SCHED; PG8_LDA(At, 0, 0); PG8_STAGE(PG8_SA(1, 1), a1 + hstep, voffA);
            PG8_WAIT_V(8); PG8_WAIT_L(0); PG8_BAR; PG8_MMA(0, 0, At, B0); PG8_MMA(0, 1, At, B1); PG8_BAR; PG8_SCHED;
            PG8_LDA(At, 0, 1); PG8_STAGE(PG8_SB(0, 0), b2, voffB); PG8_STAGE(PG8_SB(0, 1), b2 + hstep, voffB); PG8_STAGE(PG8_SA(0, 0), a2, voffA);
            PG8_WAIT_V(8); PG8_WAIT_L(0); PG8_BAR; PG8_MMA(1, 0, At, B0); PG8_MMA(1, 1, At, B1); PG8_BAR; PG8_SCHED;
            PG8_LDB(B0, 1, 0); PG8_LDB(B1, 1, 1); PG8_SCHED; PG8_LDA(At, 1, 0); PG8_STAGE(PG8_SA(0, 1), a2 + hstep, voffA);
            PG8_WAIT_V(8); PG8_WAIT_L(0); PG8_BAR; PG8_MMA(0, 0, At, B0); PG8_MMA(0, 1, At, B1); PG8_BAR; PG8_SCHED;
            PG8_LDA(At, 1, 1); PG8_STAGE(PG8_SB(1, 0), b3, voffB); PG8_STAGE(PG8_SB(1, 1), b3 + hstep, voffB); PG8_STAGE(PG8_SA(1, 0), a3, voffA);
            PG8_WAIT_V(8); PG8_WAIT_L(0); PG8_BAR; PG8_MMA(1, 0, At, B0); PG8_MMA(1, 1, At, B1); PG8_BAR; PG8_SCHED;
            } else {
            PG8_LDB(B0, 0, 0); PG8_SCHED; PG8_LDA(At, 0, 0); PG8_STAGE(PG8_SA(1, 1), a1 + hstep, voffA);
            PG8_WAIT_L(8); PG8_BAR; PG8_WAIT_L(0); PG8_MMA(0, 0, At, B0); PG8_BAR; PG8_SCHED;
            PG8_LDB(B1, 0, 1); PG8_STAGE(PG8_SB(0, 0), b2, voffB);
            PG8_BAR; PG8_WAIT_L(0); PG8_MMA(0, 1, At, B1); PG8_BAR;
            PG8_LDA(At, 0, 1); PG8_STAGE(PG8_SA(0, 0), a2, voffA);
            PG8_BAR; PG8_WAIT_L(0); PG8_MMA(1, 0, At, B0); PG8_BAR; PG8_SCHED;
            PG8_STAGE(PG8_SB(0, 1), b2 + hstep, voffB);
            PG8_WAIT_V(6); PG8_BAR; PG8_MMA(1, 1, At, B1); PG8_BAR;
            PG8_LDB(B0, 1, 0); PG8_SCHED; PG8_LDA(At, 1, 0); PG8_STAGE(PG8_SA(0, 1), a2 + hstep, voffA);
            PG8_WAIT_L(8); PG8_BAR; PG8_WAIT_L(0); PG8_MMA(0, 0, At, B0); PG8_BAR; PG8_SCHED;
            PG8_LDB(B1, 1, 1); PG8_STAGE(PG8_SB(1, 0), b3, voffB);
            PG8_BAR; PG8_WAIT_L(0); PG8_MMA(0, 1, At, B1); PG8_BAR;
            PG8_LDA(At, 1, 1); PG8_STAGE(PG8_SA(1, 0), a3, voffA);
            PG8_BAR; PG8_WAIT_L(0); PG8_MMA(1, 0, At, B0); PG8_BAR; PG8_SCHED;
            PG8_STAGE(PG8_SB(1, 1), b3 + hstep, voffB);
            PG8_WAIT_V(6); PG8_BAR; PG8_MMA(1, 1, At, B1); PG8_BAR;
            }
        }
        if constexpr (ALIGN_EPI) { if (wr == 0) PG8_BAR; }
        if constexpr (!Epi::AFTER_DRAIN) { E(acc, cur, wr, wc, fr, fq); S.done(cur); }
        if (!has_next) break;
#pragma unroll
        for (int a = 0; a < 2; ++a)
#pragma unroll
            for (int b = 0; b < 2; ++b)
#pragma unroll
                for (int m = 0; m < 4; ++m)
#pragma unroll
                    for (int n = 0; n < 2; ++n) acc[a][b][m][n] = (f32x4){0.f, 0.f, 0.f, 0.f};
        cur = nxt; cA = nA; cB = nB; ++ui;
        if constexpr (ALIGN_EPI) { if (wr == 1) PG8_BAR; }
    }
    PG8_WAIT_V(0);
    if constexpr (!ALIGN_EPI) { if (wr == 0) PG8_BAR; }
    PG8_BAR;
    if constexpr (Epi::AFTER_DRAIN) { E.fused(acc, cur, wr, wc, fr, fq, lds, wid, lane); S.done(cur); }
#undef PG8_SA
#undef PG8_SB
#undef PG8_STAGE
#undef PG8_LDA
#undef PG8_LDB
#undef PG8_MMA
#undef PG8_WAIT_V
#undef PG8_WAIT_L
#undef PG8_BAR
#undef PG8_SCHED
}
}

#ifndef REPMASK
#define REPMASK 0
#endif
#ifndef EXTRA_SYNC
#define EXTRA_SYNC 0
#endif
#ifndef PHMASK
#define PHMASK 1023
#endif
#ifndef MK_N_LAUNCHES
#define MK_N_LAUNCHES 1
#endif
#define LAS __attribute__((address_space(3)))
typedef unsigned short bf16;
typedef unsigned u32x4 __attribute__((ext_vector_type(4)));
typedef unsigned u32x2 __attribute__((ext_vector_type(2)));
typedef float f32x4 __attribute__((ext_vector_type(4)));
typedef short bf16x8 __attribute__((ext_vector_type(8)));
typedef LAS unsigned char* ldsp;

constexpr int TP = 16384, TS = 1024, TT = TP + TS, DM = 1024, FF = 4096, PW = 3584, HW = 512;
constexpr int SEQ = 2048, NCHUNK = 32, NPU = 1024  , NSU = 512  ;
constexpr float ALPHA = 1.4142135623730951f, LN_EPS = 1e-5f, RMS_EPS = 1e-6f;
constexpr size_t MiB = 1u << 20;
constexpr size_t WS_DEC = 1 * MiB, WS_W = 2 * MiB, W_LAYER = 25 * MiB, W_IN = 0, W_OUT = 7 * MiB, W_FF1 = 9 * MiB, W_FF2 = 17 * MiB;
constexpr size_t WS_XB = 52 * MiB, WS_MIX = 86 * MiB, WS_BIG = 120 * MiB;
constexpr size_t WS_QB = WS_BIG, WS_LF = WS_BIG + 17 * MiB, WS_VB = WS_BIG + 51 * MiB, WS_GB = WS_BIG + 68 * MiB, WS_BB = WS_BIG + 85 * MiB, WS_UB = WS_BIG + 102 * MiB;
constexpr size_t WS_HID = WS_BIG, WS_END = 256 * MiB;
constexpr size_t O_Y = 0, O_HP = (size_t)TT * DM, O_CP = O_HP + 2 * 8 * 4 * 16384, O_HS = O_CP + 2 * 8 * 2 * 512, O_CS = O_HS + (size_t)2 * 128 * 4 * 16384, O_END = O_CS + 2 * 128 * 2 * 512;
constexpr int LDS_BYTES = 147456;
constexpr int NPHASE = 19;
constexpr int CW_BAR = 4096;

__device__ __forceinline__ float bflo(unsigned w) { return __uint_as_float(w << 16); }
__device__ __forceinline__ float bfhi(unsigned w) { return __uint_as_float(w & 0xffff0000u); }
__device__ __forceinline__ float bf1(bf16 h) { return __uint_as_float(((unsigned)h) << 16); }
__device__ __forceinline__ unsigned pk(float lo, float hi) { return pg8::cvt_pk_bf16(lo, hi); }
__device__ __forceinline__ bf16 tobf(float x) { return (bf16)(pg8::cvt_pk_bf16(x, 0.f) & 0xffffu); }
__device__ __forceinline__ float silu_f(float x) { return x / (1.f + __expf(-x)); }
__device__ __forceinline__ float wave_sum(float v) {
#pragma unroll
    for (int o = 1; o < 64; o <<= 1) v += __shfl_xor(v, o);
    return v;
}
#define MFMA16(a, b, c) __builtin_amdgcn_mfma_f32_16x16x32_bf16((a), (b), (c), 0, 0, 0)

struct EpiProj {
    static constexpr bool PERM = true, AFTER_DRAIN = false;
    bf16 *QB, *VB, *GB, *BB, *UB; float* LF; const float* lbl; int layer;
    __device__ __forceinline__ void operator()(const f32x4 (&acc)[2][2][4][2], const pg8::Unit& u, int wr, int wc, int fr, int fq) const {
        const int row0 = u.pm * 256 + wr * 64 + fr, cw = wc * 32 + 8 * fq;
        if (u.pn >= 10) {
            const int col = (u.pn - 10) * 128 + cw;
#pragma unroll
            for (int ai = 0; ai < 2; ++ai)
#pragma unroll
                for (int m = 0; m < 4; ++m) {
                    const f32x4 v0 = acc[ai][0][m][0] * acc[ai][1][m][0], v1 = acc[ai][0][m][1] * acc[ai][1][m][1];
                    u32x4 w; w.x = pk(v0[0], v0[1]); w.y = pk(v0[2], v0[3]); w.z = pk(v1[0], v1[1]); w.w = pk(v1[2], v1[3]);
                    *(u32x4*)(UB + (size_t)(row0 + ai * 128 + m * 16) * HW + col) = w;
                }
        } else {
            const int blk = u.pn >> 1, cb = (u.pn & 1) * 256 + cw;
            if (blk == 1) {
                f32x4 lb[2][2];
#pragma unroll
                for (int bj = 0; bj < 2; ++bj)
#pragma unroll
                    for (int n = 0; n < 2; ++n)
#pragma unroll
                        for (int e = 0; e < 4; ++e) { const int col = cb + bj * 128 + 4 * n + e; lb[bj][n][e] = (layer == 0) ? 0.f : 1.f / (1.f + __expf(lbl[col] - lbl[HW + col])); }
#pragma unroll
                for (int ai = 0; ai < 2; ++ai)
#pragma unroll
                    for (int m = 0; m < 4; ++m)
#pragma unroll
                        for (int bj = 0; bj < 2; ++bj) {
                            float* dst = LF + (size_t)(row0 + ai * 128 + m * 16) * HW + cb + bj * 128;
#pragma unroll
                            for (int n = 0; n < 2; ++n) {
                                f32x4 o;
#pragma unroll
                                for (int e = 0; e < 4; ++e) {
                                    const float z = acc[ai][bj][m][n][e], l = lb[bj][n][e];
                                    const float ls = fminf(z, 0.f) - __logf(1.f + __expf(-fabsf(z)));
                                    o[e] = (l > 0.f) ? __logf(l + (1.f - l) * __expf(ls)) : ls;
                                }
                                *(f32x4*)(dst + 4 * n) = o;
                            }
                        }
            } else {
                bf16* dst0 = (blk == 0) ? QB : (blk == 2) ? VB : (blk == 3) ? GB : BB;
                const bool act = (blk == 0) || (blk == 3);
#pragma unroll
                for (int ai = 0; ai < 2; ++ai)
#pragma unroll
                    for (int m = 0; m < 4; ++m)
#pragma unroll
                        for (int bj = 0; bj < 2; ++bj) {
                            f32x4 v0 = acc[ai][bj][m][0], v1 = acc[ai][bj][m][1];
                            if (act) {
#pragma unroll
                                for (int e = 0; e < 4; ++e) { v0[e] = silu_f(v0[e]); v1[e] = silu_f(v1[e]); }
                            }
                            u32x4 w; w.x = pk(v0[0], v0[1]); w.y = pk(v0[2], v0[3]); w.z = pk(v1[0], v1[1]); w.w = pk(v1[2], v1[3]);
                            *(u32x4*)(dst0 + (size_t)(row0 + ai * 128 + m * 16) * HW + cb + bj * 128) = w;
                        }
            }
        }
    }
};
struct EpiRes {
    static constexpr bool PERM = true, AFTER_DRAIN = false;
    const bf16* res; bf16* out;
    __device__ __forceinline__ void operator()(const f32x4 (&acc)[2][2][4][2], const pg8::Unit& u, int wr, int wc, int fr, int fq) const {
        const int row0 = u.pm * 256 + wr * 64 + fr, c0 = u.pn * 256 + wc * 32 + 8 * fq;
#pragma unroll
        for (int ai = 0; ai < 2; ++ai)
#pragma unroll
            for (int m = 0; m < 4; ++m)
#pragma unroll
                for (int bj = 0; bj < 2; ++bj) {
                    const size_t off = (size_t)(row0 + ai * 128 + m * 16) * DM + c0 + bj * 128;
                    const u32x4 r = *(const u32x4*)(res + off);
                    const f32x4 a0 = acc[ai][bj][m][0], a1 = acc[ai][bj][m][1];
                    u32x4 w;
                    w.x = pk(a0[0] + ALPHA * bflo(r.x), a0[1] + ALPHA * bfhi(r.x)); w.y = pk(a0[2] + ALPHA * bflo(r.y), a0[3] + ALPHA * bfhi(r.y));
                    w.z = pk(a1[0] + ALPHA * bflo(r.z), a1[1] + ALPHA * bfhi(r.z)); w.w = pk(a1[2] + ALPHA * bflo(r.w), a1[3] + ALPHA * bfhi(r.w));
                    *(u32x4*)(out + off) = w;
                }
    }
};
struct EpiRelu2 {
    static constexpr bool PERM = true, AFTER_DRAIN = false;
    bf16* out;
    __device__ __forceinline__ void operator()(const f32x4 (&acc)[2][2][4][2], const pg8::Unit& u, int wr, int wc, int fr, int fq) const {
        const int row0 = u.pm * 256 + wr * 64 + fr, c0 = u.pn * 256 + wc * 32 + 8 * fq;
#pragma unroll
        for (int ai = 0; ai < 2; ++ai)
#pragma unroll
            for (int m = 0; m < 4; ++m)
#pragma unroll
                for (int bj = 0; bj < 2; ++bj) {
                    f32x4 a0 = acc[ai][bj][m][0], a1 = acc[ai][bj][m][1];
#pragma unroll
                    for (int e = 0; e < 4; ++e) { const float x = fmaxf(a0[e], 0.f), y = fmaxf(a1[e], 0.f); a0[e] = x * x; a1[e] = y * y; }
                    u32x4 w; w.x = pk(a0[0], a0[1]); w.y = pk(a0[2], a0[3]); w.z = pk(a1[0], a1[1]); w.w = pk(a1[2], a1[3]);
                    *(u32x4*)(out + (size_t)(row0 + ai * 128 + m * 16) * FF + c0 + bj * 128) = w;
                }
    }
};

__device__ __forceinline__ int remap_in(int n0) {
    if (n0 < 2560) return n0;
    if (n0 < 3072) { const int c = n0 - 2560; return 2560 + 256 * (c >> 7) + (c & 127); }
    const int c = n0 - 3072; return 2560 + 256 * (c >> 7) + 128 + (c & 127);
}
__device__ __forceinline__ void transpose_item(const float* W, int K, int N, bf16* WT, bool remap, LAS float* scr, int item, int lane) {
    const int nblk = N / 32, kb = item / nblk, nb = item % nblk, k0 = 64 * kb, n0 = 32 * nb;
    const int d0 = remap ? remap_in(n0) : n0;
#pragma unroll 8
    for (int i = 0; i < 32; ++i) { const int kk = 2 * i + (lane >> 5); scr[kk * 33 + (lane & 31)] = W[(size_t)(k0 + kk) * N + n0 + (lane & 31)]; }
    asm volatile("s_waitcnt lgkmcnt(0)" ::: "memory");
    const int c = lane & 7;
#pragma unroll
    for (int j = 0; j < 4; ++j) { const int n = (lane >> 3) + 8 * j; const LAS float* s = scr + (8 * c) * 33 + n;
        u32x4 o; o.x = pk(s[0 * 33], s[1 * 33]); o.y = pk(s[2 * 33], s[3 * 33]); o.z = pk(s[4 * 33], s[5 * 33]); o.w = pk(s[6 * 33], s[7 * 33]);
        *(u32x4*)(WT + (size_t)(d0 + n) * K + k0 + 8 * c) = o; }
    asm volatile("s_waitcnt lgkmcnt(0)" ::: "memory");
}
__device__ __forceinline__ void p0_phase(ldsp lds, const float* const* in, unsigned char* ws, int gw, int ngw, int wave, int lane) {
    LAS float* scr = (LAS float*)(lds + wave * 16384);
    constexpr int I_IN = 16 * 112, I_OUT = 16 * 32, I_F1 = 16 * 128, I_F2 = 64 * 32, I_L = I_IN + I_OUT + I_F1 + I_F2;
    for (int it = gw; it < 2 * I_L; it += ngw) {
        const int l = it / I_L; int r = it % I_L;
        unsigned char* wl = ws + WS_W + (size_t)l * W_LAYER;
        if (r < I_IN) { transpose_item(in[4] + (size_t)l * DM * PW, DM, PW, (bf16*)(wl + W_IN), true, scr, r, lane); continue; } r -= I_IN;
        if (r < I_OUT) { transpose_item(in[8] + (size_t)l * DM * DM, DM, DM, (bf16*)(wl + W_OUT), false, scr, r, lane); continue; } r -= I_OUT;
        if (r < I_F1) { transpose_item(in[11] + (size_t)l * DM * FF, DM, FF, (bf16*)(wl + W_FF1), false, scr, r, lane); continue; } r -= I_F1;
        transpose_item(in[12] + (size_t)l * FF * DM, FF, DM, (bf16*)(wl + W_FF2), false, scr, r, lane);
    }
    bf16* XB = (bf16*)(ws + WS_XB);
    for (int r = gw; r < TT; r += ngw) {
        const float* src = (r < TP) ? in[0] + (size_t)r * DM : in[1] + (size_t)(r - TP) * DM;
#pragma unroll
        for (int j = 0; j < 4; ++j) { const f32x4 v = *(const f32x4*)(src + 4 * lane + 256 * j); u32x2 w; w.x = pk(v[0], v[1]); w.y = pk(v[2], v[3]); *(u32x2*)(XB + (size_t)r * DM + 4 * lane + 256 * j) = w; }
    }
}

constexpr int L_BS = 0, L_QS = 32768, L_KS = 50176, L_KT = 32768, L_VT = 67584, L_ST = 86016, L_PP = 120832, L_SEG = 130048, L_RED = 132096;
constexpr int RS128 = 272, RS64 = 144;

__device__ __forceinline__ void load_cumsum(ldsp lds, const float* LF, int tok0, int h, float (&kk)[16], int tid) {
    LAS float* BS = (LAS float*)(lds + L_BS); LAS float* SEG = (LAS float*)(lds + L_SEG);
#pragma unroll
    for (int j = 0; j < 4; ++j) { const int idx = tid + 512 * j, t = idx >> 5, c4 = idx & 31;
        *(LAS f32x4*)(BS + t * 128 + 4 * c4) = *(const f32x4*)(LF + (size_t)(tok0 + t) * HW + h * 128 + 4 * c4); }
    __syncthreads();
    const int c = tid & 127, sg = tid >> 7;
    float run = 0.f;
#pragma unroll
    for (int i = 0; i < 16; ++i) { const int t = sg * 16 + i; const float lf = BS[t * 128 + c]; kk[i] = -expm1f(lf); run += lf; BS[t * 128 + c] = run; }
    SEG[sg * 128 + c] = run;
    __syncthreads();
    float off = 0.f;
    for (int s = 0; s < sg; ++s) off += SEG[s * 128 + c];
#pragma unroll
    for (int i = 0; i < 16; ++i) BS[(sg * 16 + i) * 128 + c] += off;
    __syncthreads();
}
__device__ __forceinline__ void load_vt(ldsp lds, const bf16* VB, int tok0, int h, int tid) {
    const int c2 = tid & 63, sgp = tid >> 6;
    unsigned w[8];
#pragma unroll
    for (int e = 0; e < 8; ++e) w[e] = *(const unsigned*)(VB + (size_t)(tok0 + 8 * sgp + e) * HW + h * 128 + 2 * c2);
    u32x4 lo, hi;
    lo.x = (w[0] & 0xffffu) | (w[1] << 16); lo.y = (w[2] & 0xffffu) | (w[3] << 16); lo.z = (w[4] & 0xffffu) | (w[5] << 16); lo.w = (w[6] & 0xffffu) | (w[7] << 16);
    hi.x = (w[0] >> 16) | (w[1] & 0xffff0000u); hi.y = (w[2] >> 16) | (w[3] & 0xffff0000u); hi.z = (w[4] >> 16) | (w[5] & 0xffff0000u); hi.w = (w[6] >> 16) | (w[7] & 0xffff0000u);
    *(LAS u32x4*)(lds + L_VT + (2 * c2) * RS64 + 16 * sgp) = lo;
    *(LAS u32x4*)(lds + L_VT + (2 * c2 + 1) * RS64 + 16 * sgp) = hi;
}

__device__ __forceinline__ void h1_prompt_unit(ldsp lds, int unit, const float* LF, const bf16* VB, float* Lbuf, float* DEC, int tid, int wave, int lane) {
    const int bh = unit >> 5, n = unit & 31, b = bh >> 2, h = bh & 3, tok0 = b * SEQ + n * 64;
    float kk[16];
    load_cumsum(lds, LF, tok0, h, kk, tid);
    LAS float* BS = (LAS float*)(lds + L_BS);
    const int c = tid & 127, sg = tid >> 7;
    const float blast = BS[63 * 128 + c];
#pragma unroll
    for (int hf = 0; hf < 2; ++hf) {
        float kd[8];
#pragma unroll
        for (int e = 0; e < 8; ++e) { const int i = hf * 8 + e; kd[e] = kk[i] * __expf(blast - BS[(sg * 16 + i) * 128 + c]); }
        u32x4 w; w.x = pk(kd[0], kd[1]); w.y = pk(kd[2], kd[3]); w.z = pk(kd[4], kd[5]); w.w = pk(kd[6], kd[7]);
        *(LAS u32x4*)(lds + L_KT + c * RS64 + (sg * 16 + hf * 8) * 2) = w;
    }
    if (sg == 0) DEC[unit * 128 + c] = __expf(blast);
    load_vt(lds, VB, tok0, h, tid);
    __syncthreads();
    const int fr = lane & 15, fq = lane >> 4;
    bf16x8 bk[2];
#pragma unroll
    for (int k2 = 0; k2 < 2; ++k2) bk[k2] = *(const LAS bf16x8*)(lds + L_KT + (16 * wave + fr) * RS64 + (32 * k2 + 8 * fq) * 2);
    float* Lu = Lbuf + (size_t)unit * 16384;
#pragma unroll
    for (int mt = 0; mt < 8; ++mt) {
        f32x4 acc = {0.f, 0.f, 0.f, 0.f};
#pragma unroll
        for (int k2 = 0; k2 < 2; ++k2) { const bf16x8 a = *(const LAS bf16x8*)(lds + L_VT + (16 * mt + fr) * RS64 + (32 * k2 + 8 * fq) * 2); acc = MFMA16(a, bk[k2], acc); }
        *(f32x4*)(Lu + (16 * wave + fr) * 128 + 16 * mt + 4 * fq) = acc;
    }
}

__device__ __forceinline__ void h_sample_unit(ldsp lds, int su, int layer, const float* LF, const bf16* QB, const bf16* VB, const bf16* GB, const float* state_hgrn, const float* onorm,
                                              bf16* MIX, float* out, int tid, int wave, int lane) {
    const int b = su >> 2, h = su & 3, R0 = TP + b * 8;
    LAS float* bs = (LAS float*)(lds + 0); LAS float* kkS = (LAS float*)(lds + 4096); LAS float* qq = (LAS float*)(lds + 8192); LAS float* aq = (LAS float*)(lds + 12288);
    LAS float* kd = (LAS float*)(lds + 16384); LAS float* vv = (LAS float*)(lds + 20480); LAS float* sc = (LAS float*)(lds + 24576); LAS float* part = (LAS float*)(lds + 32768);
    {
        const int c = tid & 127, p = tid >> 7;
        if (p == 0) {
            float run = 0.f;
#pragma unroll
            for (int t = 0; t < 8; ++t) { const float lf = LF[(size_t)(R0 + t) * HW + h * 128 + c]; kkS[t * 128 + c] = -expm1f(lf); run += lf; bs[t * 128 + c] = run; }
#pragma unroll
            for (int t = 0; t < 8; ++t) { const float bt = bs[t * 128 + c]; const float q = bf1(QB[(size_t)(R0 + t) * HW + h * 128 + c]);
                qq[t * 128 + c] = q; aq[t * 128 + c] = q * __expf(bt); kd[t * 128 + c] = kkS[t * 128 + c] * __expf(run - bt); }
        } else if (p == 1) {
#pragma unroll
            for (int t = 0; t < 8; ++t) vv[t * 128 + c] = bf1(VB[(size_t)(R0 + t) * HW + h * 128 + c]);
        }
    }
    __syncthreads();
    {
        const int pair = tid >> 3, t = pair >> 3, s = pair & 7, sub = tid & 7;
        float sum = 0.f;
        if (s <= t) {
#pragma unroll
            for (int e = 0; e < 16; ++e) { const int c = sub * 16 + e; sum += qq[t * 128 + c] * __expf(bs[t * 128 + c] - bs[s * 128 + c]) * kkS[s * 128 + c]; }
        }
        sum += __shfl_xor(sum, 1); sum += __shfl_xor(sum, 2); sum += __shfl_xor(sum, 4);
        if (sub == 0) sc[t * 8 + s] = sum;
    }
    __syncthreads();
    {
        const int v4 = tid & 31, kg = tid >> 5;
        const size_t so = (((size_t)layer * 128 + b) * 4 + h) * 16384;
        const float* S0 = state_hgrn + so; float* SN = out + O_HS + so;
        f32x4 op[8];
#pragma unroll
        for (int t = 0; t < 8; ++t) op[t] = (f32x4){0.f, 0.f, 0.f, 0.f};
#pragma unroll
        for (int i = 0; i < 8; ++i) {
            const int k = 8 * kg + i;
            const f32x4 s0 = *(const f32x4*)(S0 + k * 128 + 4 * v4);
#pragma unroll
            for (int t = 0; t < 8; ++t) op[t] += aq[t * 128 + k] * s0;
            f32x4 sn = s0 * __expf(bs[7 * 128 + k]);
#pragma unroll
            for (int s = 0; s < 8; ++s) sn += kd[s * 128 + k] * (*(const LAS f32x4*)(vv + s * 128 + 4 * v4));
            *(f32x4*)(SN + k * 128 + 4 * v4) = sn;
        }
#pragma unroll
        for (int t = 0; t < 8; ++t) {
#pragma unroll
            for (int e = 0; e < 4; ++e) op[t][e] += __shfl_xor(op[t][e], 32);
            if (lane < 32) *(LAS f32x4*)(part + (wave * 8 + t) * 128 + 4 * v4) = op[t];
        }
    }
    __syncthreads();
    {
        const int t = wave, v = 2 * lane;
        float o0 = 0.f, o1 = 0.f;
#pragma unroll
        for (int w = 0; w < 8; ++w) { o0 += part[(w * 8 + t) * 128 + v]; o1 += part[(w * 8 + t) * 128 + v + 1]; }
        for (int s = 0; s <= t; ++s) { const float p = sc[t * 8 + s]; o0 += p * vv[s * 128 + v]; o1 += p * vv[s * 128 + v + 1]; }
        const float rstd = rsqrtf(wave_sum(o0 * o0 + o1 * o1) * (1.f / 128.f) + RMS_EPS);
        const unsigned g = *(const unsigned*)(GB + (size_t)(R0 + t) * HW + h * 128 + v);
        const float on0 = onorm[layer * HW + h * 128 + v], on1 = onorm[layer * HW + h * 128 + v + 1];
        *(unsigned*)(MIX + (size_t)(R0 + t) * DM + h * 128 + v) = pk(o0 * rstd * on0 * bflo(g), o1 * rstd * on1 * bfhi(g));
    }
}

__device__ __forceinline__ void h3_prompt_unit(ldsp lds, int unit, int layer, const float* LF, const bf16* QB, const bf16* VB, const bf16* GB, const float* Sbuf, const float* onorm,
                                               bf16* MIX, int tid, int wave, int lane) {
    const int bh = unit >> 5, n = unit & 31, b = bh >> 2, h = bh & 3, tok0 = b * SEQ + n * 64;
    float kk[16];
    load_cumsum(lds, LF, tok0, h, kk, tid);
    LAS float* BS = (LAS float*)(lds + L_BS);
    {
        const int c = tid & 127, sg = tid >> 7;
        const float bref = BS[31 * 128 + c];
#pragma unroll
        for (int i = 0; i < 16; ++i) {
            const int t = sg * 16 + i; const float bt = BS[t * 128 + c];
            const float q = bf1(QB[(size_t)(tok0 + t) * HW + h * 128 + c]);
            *(LAS bf16*)(lds + L_QS + t * RS128 + 2 * c) = tobf(q * __expf(fminf(bt - bref, 80.f)));
            *(LAS bf16*)(lds + L_KS + t * RS128 + 2 * c) = tobf(kk[i] * __expf(fminf(bref - bt, 80.f)));
        }
    }
    load_vt(lds, VB, tok0, h, tid);
    {
        const int v = tid & 127, kg = tid >> 7;
        const float* Su = Sbuf + (size_t)unit * 16384;
#pragma unroll
        for (int i8 = 0; i8 < 4; ++i8) {
            const int k0 = 32 * kg + 8 * i8;
            float s[8];
#pragma unroll
            for (int e = 0; e < 8; ++e) s[e] = Su[(k0 + e) * 128 + v] * __expf(BS[31 * 128 + k0 + e]);
            u32x4 w; w.x = pk(s[0], s[1]); w.y = pk(s[2], s[3]); w.z = pk(s[4], s[5]); w.w = pk(s[6], s[7]);
            *(LAS u32x4*)(lds + L_ST + v * RS128 + k0 * 2) = w;
        }
    }
    __syncthreads();
    const int fr = lane & 15, fq = lane >> 4, tm = wave >> 1;
    {
        const int ts0 = (wave & 1) * 2;
        f32x4 sc[2] = {{0.f, 0.f, 0.f, 0.f}, {0.f, 0.f, 0.f, 0.f}};
#pragma unroll
        for (int k2 = 0; k2 < 4; ++k2) {
            const bf16x8 a = *(const LAS bf16x8*)(lds + L_QS + (16 * tm + fr) * RS128 + (32 * k2 + 8 * fq) * 2);
#pragma unroll
            for (int i = 0; i < 2; ++i) { const bf16x8 bb = *(const LAS bf16x8*)(lds + L_KS + (16 * (ts0 + i) + fr) * RS128 + (32 * k2 + 8 * fq) * 2); sc[i] = MFMA16(a, bb, sc[i]); }
        }
#pragma unroll
        for (int i = 0; i < 2; ++i)
#pragma unroll
            for (int j = 0; j < 4; ++j) { const int t = 16 * tm + 4 * fq + j, s = 16 * (ts0 + i) + fr;
                *(LAS bf16*)(lds + L_PP + t * RS64 + 2 * s) = tobf((s <= t) ? sc[i][j] : 0.f); }
    }
    __syncthreads();
    const int vh = wave & 1;
    f32x4 o[4];
#pragma unroll
    for (int i = 0; i < 4; ++i) o[i] = (f32x4){0.f, 0.f, 0.f, 0.f};
#pragma unroll
    for (int k2 = 0; k2 < 4; ++k2) {
        const bf16x8 bq = *(const LAS bf16x8*)(lds + L_QS + (16 * tm + fr) * RS128 + (32 * k2 + 8 * fq) * 2);
#pragma unroll
        for (int i = 0; i < 4; ++i) { const bf16x8 a = *(const LAS bf16x8*)(lds + L_ST + (16 * (4 * vh + i) + fr) * RS128 + (32 * k2 + 8 * fq) * 2); o[i] = MFMA16(a, bq, o[i]); }
    }
#pragma unroll
    for (int k2 = 0; k2 < 2; ++k2) {
        const bf16x8 bp = *(const LAS bf16x8*)(lds + L_PP + (16 * tm + fr) * RS64 + (32 * k2 + 8 * fq) * 2);
#pragma unroll
        for (int i = 0; i < 4; ++i) { const bf16x8 a = *(const LAS bf16x8*)(lds + L_VT + (16 * (4 * vh + i) + fr) * RS64 + (32 * k2 + 8 * fq) * 2); o[i] = MFMA16(a, bp, o[i]); }
    }
    float ss = 0.f;
#pragma unroll
    for (int i = 0; i < 4; ++i) ss += (o[i][0] * o[i][0] + o[i][1] * o[i][1]) + (o[i][2] * o[i][2] + o[i][3] * o[i][3]);
    ss += __shfl_xor(ss, 16); ss += __shfl_xor(ss, 32);
    LAS float* RED = (LAS float*)(lds + L_RED);
    if (fq == 0) RED[vh * 64 + 16 * tm + fr] = ss;
    __syncthreads();
    const float rstd = rsqrtf((RED[16 * tm + fr] + RED[64 + 16 * tm + fr]) * (1.f / 128.f) + RMS_EPS);
    const size_t row = (size_t)(tok0 + 16 * tm + fr);
#pragma unroll
    for (int i = 0; i < 4; ++i) {
        const int vc = h * 128 + 16 * (4 * vh + i) + 4 * fq;
        const u32x2 g = *(const u32x2*)(GB + row * HW + vc);
        const f32x4 on = *(const f32x4*)(onorm + layer * HW + vc);
        u32x2 w; w.x = pk(o[i][0] * rstd * on[0] * bflo(g.x), o[i][1] * rstd * on[1] * bfhi(g.x)); w.y = pk(o[i][2] * rstd * on[2] * bflo(g.y), o[i][3] * rstd * on[3] * bfhi(g.y));
        *(u32x2*)(MIX + row * DM + vc) = w;
    }
}

__device__ __forceinline__ void h2_phase(int layer, float* Lbuf, const float* DEC, float* out, const bf16* UB, const bf16* BB, const float* state_conv, const float* conv_w, bf16* MIX, int gtid, int ngt) {
    for (int g = gtid; g < 32 * 4096; g += ngt) {
        const int bh = g >> 12, k = (g >> 5) & 127, v4 = g & 31;
        f32x4 S = {0.f, 0.f, 0.f, 0.f};
        float* Lp = Lbuf + (size_t)bh * 32 * 16384 + k * 128 + 4 * v4;
        const float* dp = DEC + bh * 32 * 128 + k;
        f32x4 l0[8], l1[8]; float d0[8], d1[8];
#pragma unroll
        for (int j = 0; j < 8; ++j) { l0[j] = *(const f32x4*)(Lp + (size_t)j * 16384); d0[j] = dp[j * 128]; }
#pragma unroll
        for (int n0 = 0; n0 < NCHUNK; n0 += 16) {
#pragma unroll
            for (int j = 0; j < 8; ++j) { l1[j] = *(const f32x4*)(Lp + (size_t)(n0 + 8 + j) * 16384); d1[j] = dp[(n0 + 8 + j) * 128]; }
#pragma unroll
            for (int j = 0; j < 8; ++j) { *(f32x4*)(Lp + (size_t)(n0 + j) * 16384) = S; S = S * d0[j] + l0[j]; }
            if (n0 + 16 < NCHUNK) {
#pragma unroll
                for (int j = 0; j < 8; ++j) { l0[j] = *(const f32x4*)(Lp + (size_t)(n0 + 16 + j) * 16384); d0[j] = dp[(n0 + 16 + j) * 128]; }
            }
#pragma unroll
            for (int j = 0; j < 8; ++j) { *(f32x4*)(Lp + (size_t)(n0 + 8 + j) * 16384) = S; S = S * d1[j] + l1[j]; }
        }
        *(f32x4*)(out + O_HP + ((size_t)layer * 32 + bh) * 16384 + k * 128 + 4 * v4) = S;
    }
    for (int g = gtid; g < TT * 64; g += ngt) {
        const int r = g >> 6, c = (g & 63) * 8;
        int t, bsm = -1, row0;
        if (r < TP) { t = r & (SEQ - 1); row0 = r - t; } else { const int q = r - TP; t = q & 7; bsm = q >> 3; row0 = r - t; }
        float u0[8], u1[8], u2[8];
        { const u32x4 w = *(const u32x4*)(UB + (size_t)r * HW + c); u2[0] = bflo(w.x); u2[1] = bfhi(w.x); u2[2] = bflo(w.y); u2[3] = bfhi(w.y); u2[4] = bflo(w.z); u2[5] = bfhi(w.z); u2[6] = bflo(w.w); u2[7] = bfhi(w.w); }
        if (t >= 1) { const u32x4 w = *(const u32x4*)(UB + (size_t)(r - 1) * HW + c); u1[0] = bflo(w.x); u1[1] = bfhi(w.x); u1[2] = bflo(w.y); u1[3] = bfhi(w.y); u1[4] = bflo(w.z); u1[5] = bfhi(w.z); u1[6] = bflo(w.w); u1[7] = bfhi(w.w); }
        else {
#pragma unroll
            for (int e = 0; e < 8; ++e) u1[e] = (bsm >= 0) ? state_conv[(((size_t)layer * 128 + bsm) * 2 + 1) * HW + c + e] : 0.f;
        }
        if (t >= 2) { const u32x4 w = *(const u32x4*)(UB + (size_t)(r - 2) * HW + c); u0[0] = bflo(w.x); u0[1] = bfhi(w.x); u0[2] = bflo(w.y); u0[3] = bfhi(w.y); u0[4] = bflo(w.z); u0[5] = bfhi(w.z); u0[6] = bflo(w.w); u0[7] = bfhi(w.w); }
        else {
#pragma unroll
            for (int e = 0; e < 8; ++e) u0[e] = (bsm >= 0) ? state_conv[(((size_t)layer * 128 + bsm) * 2 + t) * HW + c + e] : 0.f;
        }
        const u32x4 gb = *(const u32x4*)(BB + (size_t)r * HW + c);
        float gv[8] = {bflo(gb.x), bfhi(gb.x), bflo(gb.y), bfhi(gb.y), bflo(gb.z), bfhi(gb.z), bflo(gb.w), bfhi(gb.w)};
        float y[8];
#pragma unroll
        for (int e = 0; e < 8; ++e) { const float w0 = conv_w[(layer * 3 + 0) * HW + c + e], w1 = conv_w[(layer * 3 + 1) * HW + c + e], w2 = conv_w[(layer * 3 + 2) * HW + c + e];
            y[e] = gv[e] * (w0 * u0[e] + w1 * u1[e] + w2 * u2[e]); }
        u32x4 w; w.x = pk(y[0], y[1]); w.y = pk(y[2], y[3]); w.z = pk(y[4], y[5]); w.w = pk(y[6], y[7]);
        *(u32x4*)(MIX + (size_t)r * DM + HW + c) = w;
        (void)row0;
        if (bsm < 0) { if (t >= SEQ - 2) { float* d = out + O_CP + (((size_t)layer * 8 + (r >> 11)) * 2 + (t - (SEQ - 2))) * HW + c;
#pragma unroll
                for (int e = 0; e < 8; ++e) d[e] = u2[e]; } }
        else { if (t >= 6) { float* d = out + O_CS + (((size_t)layer * 128 + bsm) * 2 + (t - 6)) * HW + c;
#pragma unroll
                for (int e = 0; e < 8; ++e) d[e] = u2[e]; } }
    }
}

__device__ __forceinline__ void ln_phase(bf16* X, const float* g, const float* bta, float* yout, int gw, int ngw, int lane) {
    for (int r = gw; r < TT; r += ngw) {
        bf16* xr = X + (size_t)r * DM;
        const u32x4 a0 = *(const u32x4*)(xr + 8 * lane), a1 = *(const u32x4*)(xr + 512 + 8 * lane);
        float v[16] = {bflo(a0.x), bfhi(a0.x), bflo(a0.y), bfhi(a0.y), bflo(a0.z), bfhi(a0.z), bflo(a0.w), bfhi(a0.w),
                       bflo(a1.x), bfhi(a1.x), bflo(a1.y), bfhi(a1.y), bflo(a1.z), bfhi(a1.z), bflo(a1.w), bfhi(a1.w)};
        float s = 0.f;
#pragma unroll
        for (int e = 0; e < 16; ++e) s += v[e];
        const float mean = wave_sum(s) * (1.f / DM);
        float s2 = 0.f;
#pragma unroll
        for (int e = 0; e < 16; ++e) { v[e] -= mean; s2 += v[e] * v[e]; }
        const float rstd = rsqrtf(wave_sum(s2) * (1.f / DM) + LN_EPS);
#pragma unroll
        for (int hf = 0; hf < 2; ++hf) {
            const int c = hf * 512 + 8 * lane;
            const f32x4 g0 = *(const f32x4*)(g + c), g1 = *(const f32x4*)(g + c + 4), b0 = *(const f32x4*)(bta + c), b1 = *(const f32x4*)(bta + c + 4);
            f32x4 y0, y1;
#pragma unroll
            for (int e = 0; e < 4; ++e) { y0[e] = v[hf * 8 + e] * rstd * g0[e] + b0[e]; y1[e] = v[hf * 8 + 4 + e] * rstd * g1[e] + b1[e]; }
            u32x4 w; w.x = pk(y0[0], y0[1]); w.y = pk(y0[2], y0[3]); w.z = pk(y1[0], y1[1]); w.w = pk(y1[2], y1[3]);
            *(u32x4*)(xr + c) = w;
            if (yout) { *(f32x4*)(yout + (size_t)r * DM + c) = y0; *(f32x4*)(yout + (size_t)r * DM + c + 4) = y1; }
        }
    }
}

#define RLX_AGENT __ATOMIC_RELAXED, __HIP_MEMORY_SCOPE_AGENT
#define XB_TMO      128
#define XB_XCNT(j)  (256  + 64 * (j))
#define XB_XSUB(j)  (1280 + 64 * (j))
#define XB_XGEN(j)  (2304 + 64 * (j))
#define XB_TOP      3328
#define XB_TOPGEN   3392
#define XCD_BAR_WORDS 3456
#define XB_SPIN_CAP (1u << 18)

__device__ __forceinline__ unsigned xb_ld(unsigned* p)              { return __hip_atomic_load(p, __ATOMIC_RELAXED, __HIP_MEMORY_SCOPE_AGENT); }
__device__ __forceinline__ unsigned xb_add(unsigned* p, unsigned v) { return __hip_atomic_fetch_add(p, v, __ATOMIC_RELAXED, __HIP_MEMORY_SCOPE_AGENT); }
__device__ __forceinline__ unsigned xb_xcc_id() { return (unsigned)__builtin_amdgcn_s_getreg((3 << 11) | 20) & 0xFu; }
#define XB_SPIN(cond, bar) do { unsigned _sp = 0; while (cond) { __builtin_amdgcn_s_sleep(1); \
    if ((++_sp & 255u) == 0u) { if (xb_ld(&(bar)[XB_TMO])) break; if (_sp > XB_SPIN_CAP) { atomicAdd(&(bar)[XB_TMO], 1u); break; } } } } while (0)

struct XcdBarrier {
    unsigned* bar; unsigned x;
    volatile LAS unsigned* st;
};

__device__ __forceinline__ XcdBarrier xcd_barrier_post(unsigned* bar, volatile LAS unsigned* st) {
    XcdBarrier b; b.bar = bar; b.x = xb_xcc_id(); b.st = st;
    if (threadIdx.x == 0) (void)xb_add(&bar[XB_XCNT(b.x)], 1u);
    return b;
}
__device__ __forceinline__ void xcd_barrier_complete(unsigned* bar, unsigned x, unsigned& nloc, unsigned& nx) {
    const unsigned G = gridDim.x * gridDim.y * gridDim.z;
    unsigned sum, cnt, mine, sp = 0u;
    for (;;) {
        sum = 0u; cnt = 0u; mine = 0u;
#pragma unroll
        for (unsigned j = 0; j < 16; ++j) { const unsigned c = xb_ld(&bar[XB_XCNT(j)]); sum += c; cnt += (c > 0u) ? 1u : 0u; mine = (j == x) ? c : mine; }
        if (sum == G) break;
        __builtin_amdgcn_s_sleep(1);
        if ((++sp & 255u) == 0u) { if (xb_ld(&bar[XB_TMO])) break; if (sp > XB_SPIN_CAP) { atomicAdd(&bar[XB_TMO], 1u); break; } }
    }
    nloc = mine > 0u ? mine : 1u; nx = cnt > 0u ? cnt : 1u;
}

__device__ __forceinline__ void xcd_barrier(const XcdBarrier& b) {
    asm volatile("s_waitcnt vmcnt(0)" ::: "memory");
    __syncthreads();
    if (threadIdx.x == 0) {
        unsigned* bar = b.bar;
        __builtin_amdgcn_s_waitcnt(0);
        unsigned nloc = b.st[0], nx = b.st[1];
        if (nloc == 0u) { xcd_barrier_complete(bar, b.x, nloc, nx); b.st[0] = nloc; b.st[1] = nx; }
        const unsigned old = xb_add(&bar[XB_XSUB(b.x)], 1u);
        const unsigned gen = old / nloc;
        if (old + 1u == (gen + 1u) * nloc) {
            __builtin_amdgcn_fence(__ATOMIC_RELEASE, "agent");
            asm volatile("s_waitcnt vmcnt(0)" ::: "memory");
            const unsigned og = xb_add(&bar[XB_TOP], 1u);
            const unsigned tg = og / nx;
            if (og + 1u == (tg + 1u) * nx) xb_add(&bar[XB_TOPGEN], 1u);
            else XB_SPIN(xb_ld(&bar[XB_TOPGEN]) == tg, bar);
            __builtin_amdgcn_fence(__ATOMIC_ACQUIRE, "agent");
            xb_add(&bar[XB_XGEN(b.x)], 1u);
            asm volatile("s_waitcnt vmcnt(0)" ::: "memory");
        } else {
            XB_SPIN(xb_ld(&bar[XB_XGEN(b.x)]) == gen, bar);
            __builtin_amdgcn_fence(__ATOMIC_ACQUIRE, "agent");
            asm volatile("s_waitcnt vmcnt(0)" ::: "memory");
        }
    }
    __syncthreads();
}

struct Args { const float* in[15]; float* out; unsigned char* ws; int ph_lo, ph_hi; };
__global__ void __launch_bounds__(512, 2) mk_fwd(Args a) {
    extern __shared__ __attribute__((aligned(16))) unsigned char lds_raw[];
    ldsp lds = (ldsp)lds_raw;
    cg::grid_group grid = cg::this_grid();
    const int G = gridDim.x, bx = blockIdx.x;
    volatile LAS unsigned* bst = (volatile LAS unsigned*)(lds + LDS_BYTES - 64);
    if (threadIdx.x < 2) bst[threadIdx.x] = 0u;
    __syncthreads();
    const XcdBarrier bar = xcd_barrier_post((unsigned*)a.ws + CW_BAR, bst);
    for (int ph = a.ph_lo; ph < a.ph_hi; ++ph) {
        int tid = threadIdx.x; asm volatile("" : "+v"(tid));
        unsigned char* ws = a.ws; asm volatile("" : "+s"(ws));
        float* out = a.out; asm volatile("" : "+s"(out));
        const int lane = tid & 63, wave = __builtin_amdgcn_readfirstlane(tid >> 6);
        const int gw = bx * 8 + wave, ngw = G * 8;
        bf16* XB = (bf16*)(ws + WS_XB); bf16* MIX = (bf16*)(ws + WS_MIX); bf16* X1 = (bf16*)out; float* Lbuf = out; float* DEC = (float*)(ws + WS_DEC);
        bf16* QB = (bf16*)(ws + WS_QB); float* LF = (float*)(ws + WS_LF); bf16* VB = (bf16*)(ws + WS_VB); bf16* GB = (bf16*)(ws + WS_GB); bf16* BB = (bf16*)(ws + WS_BB); bf16* UB = (bf16*)(ws + WS_UB);
        bf16* HID = (bf16*)(ws + WS_HID);
        if (ph == 0 && (PHMASK & 512)) {
            p0_phase(lds, a.in, ws, gw, ngw, wave, lane);
        } else {
            const int layer = (ph - 1) / 9, kind = (ph - 1) % 9;
            const unsigned char* wl = ws + WS_W + (size_t)layer * W_LAYER;
            if (kind == 0 && (PHMASK & 1)) {
                pg8::Gemm g{(const bf16*)XB, (const bf16*)(wl + W_IN), TT, PW, DM}; pg8::StaticOrder S; S.init(TT, PW, G, bx);
                EpiProj E{QB, VB, GB, BB, UB, LF, a.in[5], layer};
                pg8::gemm_phase<EpiProj, pg8::StaticOrder, true, true>(lds, g, S, E);
            } else if (kind == 1 && (PHMASK & 2)) {
                for (int u = bx; u < NPU + NSU; u += G) {
                    __syncthreads();
                    if (u < NPU) h1_prompt_unit(lds, u, LF, VB, Lbuf, DEC, tid, wave, lane);
                    else h_sample_unit(lds, u - NPU, layer, LF, QB, VB, GB, a.in[2], a.in[7], MIX, out, tid, wave, lane);
                }
            } else if (kind == 2 && (PHMASK & 4)) {
                h2_phase(layer, Lbuf, DEC, out, UB, BB, a.in[3], a.in[6], MIX, bx * 512 + tid, G * 512);
            } else if (kind == 3 && (PHMASK & 8)) {
                for (int u = bx; u < NPU; u += G) { __syncthreads(); h3_prompt_unit(lds, u, layer, LF, QB, VB, GB, Lbuf, a.in[7], MIX, tid, wave, lane); }
            } else if ((kind == 4 || kind == 7) && (PHMASK & 16)) {
                const bool second = (kind == 7);
                pg8::Gemm g{second ? (const bf16*)HID : (const bf16*)MIX, (const bf16*)(wl + (second ? W_FF2 : W_OUT)), TT, DM, second ? FF : DM}; pg8::StaticOrder S; S.init(TT, DM, G, bx);
                EpiRes E{second ? (const bf16*)X1 : (const bf16*)XB, second ? XB : X1};
                pg8::gemm_phase<EpiRes, pg8::StaticOrder, true, true>(lds, g, S, E);
            } else if (kind == 5 && (PHMASK & 32)) {
                ln_phase(X1, a.in[9] + layer * DM, a.in[10] + layer * DM, nullptr, gw, ngw, lane);
            } else if (kind == 6 && (PHMASK & 64)) {
                pg8::Gemm g{(const bf16*)X1, (const bf16*)(wl + W_FF1), TT, FF, DM}; pg8::StaticOrder S; S.init(TT, FF, G, bx);
                EpiRelu2 E{HID};
                pg8::gemm_phase<EpiRelu2, pg8::StaticOrder, true, true>(lds, g, S, E);
            } else if (PHMASK & 256) {
                ln_phase(XB, a.in[13] + layer * DM, a.in[14] + layer * DM, (layer == 1) ? out + O_Y : nullptr, gw, ngw, lane);
            }
        }
        if (ph + 1 < a.ph_hi) { if (ph == a.ph_lo) grid.sync(); else xcd_barrier(bar); }
    }
}

extern "C" void kernel_launch(void* const* d_in, const int* in_sizes, int n_in, void* d_out, int out_size, void* d_ws, size_t ws_size, hipStream_t stream) {
    static int grid = 0;
    if (grid == 0) {
        if (n_in != 15 || in_sizes[0] != TP * DM || (size_t)out_size != O_END || ws_size < WS_END) {
            fprintf(stderr, "kernel_launch: unexpected shapes (n_in %d in0 %d out %d ws %zu); nothing launched\n", n_in, n_in > 0 ? in_sizes[0] : -1, out_size, ws_size); grid = -1; return; }
        int dev = 0, cus = 0, per_cu = 0;
        (void)hipGetDevice(&dev); (void)hipDeviceGetAttribute(&cus, hipDeviceAttributeMultiprocessorCount, dev);
        if (hipFuncSetAttribute((const void*)mk_fwd, hipFuncAttributeMaxDynamicSharedMemorySize, LDS_BYTES) != hipSuccess) { fprintf(stderr, "kernel_launch: hipFuncSetAttribute failed\n"); grid = -1; return; }
        if (hipOccupancyMaxActiveBlocksPerMultiprocessor(&per_cu, (const void*)mk_fwd, 512, LDS_BYTES) != hipSuccess || per_cu < 1) { fprintf(stderr, "kernel_launch: occupancy query says %d\n", per_cu); per_cu = 1; }
        (void)hipGetLastError();
        grid = cus > 0 ? cus : 256;
    }
    if (grid < 0) return;
    if (hipMemsetAsync(d_ws, 0, 65536, stream) != hipSuccess) { fprintf(stderr, "kernel_launch: memset failed\n"); return; }
    Args a{};
    for (int i = 0; i < 15; ++i) a.in[i] = (const float*)d_in[i];
    a.out = (float*)d_out; a.ws = (unsigned char*)d_ws;
    for (int lo = 0; lo < NPHASE; lo += (MK_N_LAUNCHES == 1 ? NPHASE : 1))
      for (int rep = 0; rep < ((MK_N_LAUNCHES != 1 && lo > 0 && ((REPMASK >> ((lo - 1) % 9)) & 1)) ? 2 : 1); ++rep) {
        a.ph_lo = lo; a.ph_hi = (MK_N_LAUNCHES == 1) ? NPHASE : lo + 1;
        void* args[] = {&a};
        const hipError_t e = hipLaunchCooperativeKernel((const void*)mk_fwd, dim3(grid), dim3(512), args, LDS_BYTES, stream);
        if (e != hipSuccess) { fprintf(stderr, "kernel_launch: cooperative launch failed: %s (grid %d)\n", hipGetErrorString(e), grid); break; }
    }
}
```

```cpp
#include <hip/hip_runtime.h>
#include <hip/hip_cooperative_groups.h>
#include <cstdio>
#include <cstdint>
namespace cg = cooperative_groups;
#define MK_N_LAUNCHES 1
#define REPMASK 0
namespace pg8 {
#define PG8_LAS __attribute__((address_space(3)))
typedef unsigned short bf16_t;
typedef short bf16x8 __attribute__((ext_vector_type(8)));
typedef float f32x4 __attribute__((ext_vector_type(4)));
typedef unsigned u32x4 __attribute__((ext_vector_type(4)));
constexpr int BM = 256, BK = 64, HALF = 128, HTB = HALF * BK * 2  , STAGE_BYTES = 8 * HTB, NXCD = 8, WGM = 8;

__host__ __device__ __forceinline__ int lds_byte(int r, int c) { const int st = (r >> 4) * 2 + (c >> 5), rr = r & 15, cc = c & 31, ob = rr * 64 + cc * 2; return st * 1024 + (ob ^ (((ob >> 9) & 1) << 5)); }
__host__ __device__ __forceinline__ void stage_rc(int b, int& R, int& C) { const int st = b / 1024, sb = b % 1024, swz = sb ^ (((sb >> 9) & 1) << 5); R = (st >> 1) * 16 + swz / 64; C = (st & 1) * 32 + (swz % 64) / 2; }
__host__ __device__ __forceinline__ int perm32(int rho) { const int n = rho >> 4, i = rho & 15; return 8 * (i >> 2) + 4 * n + (i & 3); }

struct Unit { int pm, pn, ks; };
struct Gemm { const bf16_t* A; const bf16_t* Bt; int M, N, K, ld; };

struct StaticOrder {
    int nM, nN, nwg, G, c;
    __host__ __device__ void init(int M, int N, int G_, int c_) { nM = M / BM; nN = N / BM; nwg = nM * nN; G = G_; c = c_; }
    __host__ __device__ bool next(int i, Unit& u) const {
        const long L = (long)i * G + c; if (L >= nwg) return false;
        int wgid = (int)L; { const int q = nwg / NXCD, r = nwg % NXCD, xcd = wgid % NXCD, off = wgid / NXCD; wgid = (xcd < r ? xcd * (q + 1) : r * (q + 1) + (xcd - r) * q) + off; }
        const int nig = WGM * nN, gid = wgid / nig, fm = gid * WGM, gsz = (nM - fm) < WGM ? (nM - fm) : WGM;
        u.pm = fm + ((wgid % nig) % gsz); u.pn = (wgid % nig) / gsz; u.ks = 0; return true;
    }
    __device__ __forceinline__ void a_ready(const Unit&) const {}
    __device__ __forceinline__ void done(const Unit&) const {}
};
struct SplitOrder {
    int pm0, nN, nsplit, total, G, c;
    __host__ __device__ void init(int pm0_, int npm, int N, int nsplit_, int G_, int c_) { pm0 = pm0_; nN = N / BM; nsplit = nsplit_; total = npm * nN * nsplit_; G = G_; c = c_; }
    __host__ __device__ bool next(int i, Unit& u) const {
        const int L = i * G + c; if (L >= total) return false;
        u.ks = L % nsplit; const int tile = L / nsplit; u.pn = tile % nN; u.pm = pm0 + tile / nN; return true;
    }
    __device__ __forceinline__ void a_ready(const Unit&) const {}
    __device__ __forceinline__ void done(const Unit&) const {}
};


__device__ __forceinline__ unsigned cvt_pk_bf16(float lo, float hi) { unsigned r; asm volatile("v_cvt_pk_bf16_f32 %0, %1, %2" : "=v"(r) : "v"(lo), "v"(hi)); return r; }
template <class Epi, class Sched, bool ALIGN_EPI = false, bool SP2 = false>
__device__ __forceinline__ void gemm_phase(PG8_LAS unsigned char* lds, const Gemm g, const Sched& S, const Epi& E) {
    int tid_ = threadIdx.x; asm volatile("" : "+v"(tid_));
    const int tid = tid_, wid = __builtin_amdgcn_readfirstlane(tid >> 6), lane = tid & 63, wr = wid >> 2, wc = wid & 3, fr = lane & 15, fq = lane >> 4;
    const int K = g.ld, nt = g.K / BK;
    unsigned voffA[2], voffB[2];
#pragma unroll
    for (int i = 0; i < 2; ++i) { int R, C; stage_rc(tid * 16 + i * 8192, R, C); const int Rb = Epi::PERM ? ((R & ~31) + perm32(R & 31)) : R;
        voffA[i] = (unsigned)(R * K + C) * 2u; voffB[i] = (unsigned)(Rb * K + C) * 2u; }
    const size_t kstep = (size_t)(BK * 2);
    const size_t hstep = (size_t)HALF * K * 2;
    const size_t tstep = 2 * hstep;
    const unsigned ldsw = (unsigned)wid * 1024u;
    const int aoff = lds_byte(wr * 64 + fr, fq * 8), boff = lds_byte(wc * 32 + fr, fq * 8);
#define PG8_SA(b, h) (((b) * 2 + (h)) * HTB)
#define PG8_SB(b, h) ((4 + (b) * 2 + (h)) * HTB)
#define PG8_STAGE(bufoff, gbase, voff) do { _Pragma("unroll") for (int _i = 0; _i < 2; ++_i) \
        __builtin_amdgcn_global_load_lds((const unsigned*)((const char*)(gbase) + (voff)[_i]), (PG8_LAS unsigned*)(lds + (bufoff) + ldsw + _i * 8192), 16, 0, 0); } while (0)
#define PG8_LDA(dst, b, h) do { _Pragma("unroll") for (int m = 0; m < 4; ++m) _Pragma("unroll") for (int k = 0; k < 2; ++k) dst[m][k] = *(const PG8_LAS bf16x8*)(lds + PG8_SA(b, h) + aoff + m * 2048 + k * 1024); } while (0)
#define PG8_LDB(dst, b, h) do { _Pragma("unroll") for (int n = 0; n < 2; ++n) _Pragma("unroll") for (int k = 0; k < 2; ++k) dst[n][k] = *(const PG8_LAS bf16x8*)(lds + PG8_SB(b, h) + boff + n * 2048 + k * 1024); } while (0)
#define PG8_MMA(ai, bj, At, Bt) do { __builtin_amdgcn_s_setprio(1); _Pragma("unroll") for (int m = 0; m < 4; ++m) _Pragma("unroll") for (int n = 0; n < 2; ++n) _Pragma("unroll") for (int k = 0; k < 2; ++k) \
        acc[ai][bj][m][n] = __builtin_amdgcn_mfma_f32_16x16x32_bf16(Bt[n][k], At[m][k], acc[ai][bj][m][n], 0, 0, 0); __builtin_amdgcn_s_setprio(0); } while (0)
#define PG8_WAIT_V(n) asm volatile("s_waitcnt vmcnt(" #n ")" ::: "memory")
#define PG8_WAIT_L(n) asm volatile("s_waitcnt lgkmcnt(" #n ")" ::: "memory")
#define PG8_BAR __builtin_amdgcn_s_barrier()
#define PG8_SCHED __builtin_amdgcn_sched_barrier(0)
    Unit cur, nxt; int ui = 0;
    if (!S.next(0, cur)) return;
    f32x4 acc[2][2][4][2];
#pragma unroll
    for (int a = 0; a < 2; ++a)
#pragma unroll
        for (int b = 0; b < 2; ++b)
#pragma unroll
            for (int m = 0; m < 4; ++m)
#pragma unroll
                for (int n = 0; n < 2; ++n) acc[a][b][m][n] = (f32x4){0.f, 0.f, 0.f, 0.f};
    bf16x8 At[4][2], B0[2][2], B1[2][2];
    const size_t kslice = (size_t)g.K * 2;
    const char* cA = (const char*)g.A + (size_t)cur.pm * tstep + (size_t)cur.ks * kslice; const char* cB = (const char*)g.Bt + (size_t)cur.pn * tstep + (size_t)cur.ks * kslice;
    S.a_ready(cur);
    if constexpr (SP2) {
        PG8_STAGE(PG8_SB(0, 0), cB, voffB); PG8_STAGE(PG8_SB(0, 1), cB + hstep, voffB); PG8_STAGE(PG8_SA(0, 0), cA, voffA); PG8_STAGE(PG8_SA(0, 1), cA + hstep, voffA);
        if (wr == 1) PG8_BAR;
        PG8_WAIT_V(2); PG8_BAR;
        PG8_STAGE(PG8_SB(1, 0), cB + kstep, voffB); PG8_STAGE(PG8_SA(1, 0), cA + kstep, voffA); PG8_STAGE(PG8_SB(1, 1), cB + hstep + kstep, voffB);
        PG8_WAIT_V(6); PG8_BAR;
    } else {
        PG8_STAGE(PG8_SB(0, 0), cB, voffB); PG8_STAGE(PG8_SA(0, 0), cA, voffA); PG8_STAGE(PG8_SB(0, 1), cB + hstep, voffB); PG8_STAGE(PG8_SA(0, 1), cA + hstep, voffA);
        if (wr == 1) PG8_BAR;
        PG8_WAIT_V(4); PG8_BAR;
        PG8_STAGE(PG8_SB(1, 0), cB + kstep, voffB); PG8_STAGE(PG8_SA(1, 0), cA + kstep, voffA); PG8_STAGE(PG8_SB(1, 1), cB + hstep + kstep, voffB);
        PG8_WAIT_V(6); PG8_BAR;
    }
    for (;;) {
        const bool has_next = S.next(ui + 1, nxt);
        const char* nA = has_next ? (const char*)g.A + (size_t)nxt.pm * tstep + (size_t)nxt.ks * kslice : cA; const char* nB = has_next ? (const char*)g.Bt + (size_t)nxt.pn * tstep + (size_t)nxt.ks * kslice : cB;
        for (int t = 0; t < nt; t += 2) {
            const bool last = (t == nt - 2);
            const char* a1 = cA + (size_t)(t + 1) * kstep;
            const char* a2 = last ? nA : cA + (size_t)(t + 2) * kstep; const char* b2 = last ? nB : cB + (size_t)(t + 2) * kstep;
            const char* a3 = a2 + kstep; const char* b3 = b2 + kstep;
            if (last && has_next) S.a_ready(nxt);
            if constexpr (SP2) {
            PG8_LDB(B0, 0, 0); PG8_LDB(B1, 0, 1); PG8_SCHED; PG8_LDA(At, 0, 0); PG8_STAGE(PG8_SA(1, 1), a1 + hstep, voffA);
            PG8_WAIT_V(8); PG8_WAIT_L(0); PG8_BAR; PG8_MMA(0, 0, At, B0); PG8_MMA(0, 1, At, B1); PG8_BAR; PG8_SCHED;
            PG8_LDA(At, 0, 1); PG8_STAGE(PG8_SB(0, 0), b2, voffB); PG8_STAGE(PG8_SB(0, 1), b2 + hstep, voffB); PG8_STAGE(PG8_SA(0, 0), a2, voffA);
            PG8_WAIT_V(8); PG8_WAIT_L(0); PG8_BAR; PG8_MMA(1, 0, At, B0); PG8_MMA(1, 1, At, B1); PG8_BAR; PG8_SCHED;
            PG8_LDB(B0, 1, 0); PG8_LDB(B1, 1, 1); PG8_SCHED; PG8_LDA(At, 1, 0); PG8_STAGE(PG8_SA(0, 1), a2 + hstep, voffA);
            PG8_WAIT_V(8); PG8_WAIT_L(0); PG8_BAR; PG8_MMA(0, 0, At, B0); PG8_MMA(0, 1, At, B1); PG8_BAR; PG8_SCHED;
            PG8_LDA(At, 1, 1); PG8_STAGE(PG8_SB(1, 0), b3, voffB); PG8_STAGE(PG8_SB(1, 1), b3 + hstep, voffB); PG8_STAGE(PG8_SA(1, 0), a3, voffA);
            PG8_WAIT_V(8); PG8_WAIT_L(0); PG8_BAR; PG8_MMA(1, 0, At, B0); PG8_MMA(1, 1, At, B1); PG8_BAR; PG8_SCHED;
            } else {
            PG8_LDB(B0, 0, 0); PG8_SCHED; PG8_LDA(At, 0, 0); PG8_STAGE(PG8_SA(1, 1), a1 + hstep, voffA);
            PG8_WAIT_L(8); PG8_BAR; PG8_WAIT_L(0); PG8_MMA(0, 0, At, B0); PG8_BAR; PG8_SCHED;
            PG8_LDB(B1, 0, 1); PG8_STAGE(PG8_SB(0, 0), b2, voffB);
            PG8_BAR; PG8_WAIT_L(0); PG8_MMA(0, 1, At, B1); PG8_BAR;
            PG8_LDA(At, 0, 1); PG8_STAGE(PG8_SA(0, 0), a2, voffA);
            PG8_BAR; PG8_WAIT_L(0); PG8_MMA(1, 0, At, B0); PG8_BAR; PG8_SCHED;
            PG8_STAGE(PG8_SB(0, 1), b2 + hstep, voffB);
            PG8_WAIT_V(6); PG8_BAR; PG8_MMA(1, 1, At, B1); PG8_BAR;
            PG8_LDB(B0, 1, 0); PG8_SCHED; PG8_LDA(At, 1, 0); PG8_STAGE(PG8_SA(0, 1), a2 + hstep, voffA);
            PG8_WAIT_L(8); PG8_BAR; PG8_WAIT_L(0); PG8_MMA(0, 0, At, B0); PG8_BAR; PG8_SCHED;
            PG8_LDB(B1, 1, 1); PG8_STAGE(PG8_SB(1, 0), b3, voffB);
            PG8_BAR; PG8_WAIT_L(0); PG8_MMA(0, 1, At, B1); PG8_BAR;
            PG8_LDA(At, 1, 1); PG8_STAGE(PG8_SA(1, 0), a3, voffA);
            PG8_BAR; PG8_WAIT_L(0); PG8_MMA(1, 0, At, B0); PG8_BAR; PG8_SCHED;
            PG8_STAGE(PG8_SB(1, 1), b3 + hstep, voffB);
            PG8_WAIT_V(6); PG8_BAR; PG8_MMA(1, 1, At, B1); PG8_BAR;
            }
        }
        if constexpr (ALIGN_EPI) { if (wr == 0) PG8_BAR; }
        if constexpr (!Epi::AFTER_DRAIN) { E(acc, cur, wr, wc, fr, fq); S.done(cur); }
        if (!has_next) break;
#pragma unroll
        for (int a = 0; a < 2; ++a)
#pragma unroll
            for (int b = 0; b < 2; ++b)
#pragma unroll
                for (int m = 0; m < 4; ++m)
#pragma unroll
                    for (int n = 0; n < 2; ++n) acc[a][b][m][n] = (f32x4){0.f, 0.f, 0.f, 0.f};
        cur = nxt; cA = nA; cB = nB; ++ui;
        if constexpr (ALIGN_EPI) { if (wr == 1) PG8_BAR; }
    }
    PG8_WAIT_V(0);
    if constexpr (!ALIGN_EPI) { if (wr == 0) PG8_BAR; }
    PG8_BAR;
    if constexpr (Epi::AFTER_DRAIN) { E.fused(acc, cur, wr, wc, fr, fq, lds, wid, lane); S.done(cur); }
#undef PG8_SA
#undef PG8_SB
#undef PG8_STAGE
#undef PG8_LDA
#undef PG8_LDB
#undef PG8_MMA
#undef PG8_WAIT_V
#undef PG8_WAIT_L
#undef PG8_BAR
#undef PG8_SCHED
}
}

#ifndef REPMASK
#define REPMASK 0
#endif
#ifndef EXTRA_SYNC
#define EXTRA_SYNC 0
#endif
#ifndef PHMASK
#define PHMASK 1023
#endif
#ifndef MK_N_LAUNCHES
#define MK_N_LAUNCHES 1
#endif
#define LAS __attribute__((address_space(3)))
typedef unsigned short bf16;
typedef unsigned u32x4 __attribute__((ext_vector_type(4)));
typedef unsigned u32x2 __attribute__((ext_vector_type(2)));
typedef float f32x4 __attribute__((ext_vector_type(4)));
typedef short bf16x8 __attribute__((ext_vector_type(8)));
typedef LAS unsigned char* ldsp;

constexpr int TP = 16384, TS = 1024, TT = TP + TS, DM = 1024, FF = 4096, PW = 3584, HW = 512;
constexpr int SEQ = 2048, NCHUNK = 32, NPU = 1024  , NSU = 512  ;
constexpr float ALPHA = 1.4142135623730951f, LN_EPS = 1e-5f, RMS_EPS = 1e-6f;
constexpr size_t MiB = 1u << 20;
constexpr size_t WS_DEC = 1 * MiB, WS_W = 2 * MiB, W_LAYER = 25 * MiB, W_IN = 0, W_OUT = 7 * MiB, W_FF1 = 9 * MiB, W_FF2 = 17 * MiB;
constexpr size_t WS_XB = 52 * MiB, WS_MIX = 86 * MiB, WS_BIG = 120 * MiB;
constexpr size_t WS_QB = WS_BIG, WS_LF = WS_BIG + 17 * MiB, WS_VB = WS_BIG + 51 * MiB, WS_GB = WS_BIG + 68 * MiB, WS_BB = WS_BIG + 85 * MiB, WS_UB = WS_BIG + 102 * MiB;
constexpr size_t WS_HID = WS_BIG, WS_END = 256 * MiB;
constexpr size_t O_Y = 0, O_HP = (size_t)TT * DM, O_CP = O_HP + 2 * 8 * 4 * 16384, O_HS = O_CP + 2 * 8 * 2 * 512, O_CS = O_HS + (size_t)2 * 128 * 4 * 16384, O_END = O_CS + 2 * 128 * 2 * 512;
constexpr int LDS_BYTES = 147456;
constexpr int NPHASE = 19;
constexpr int NSPLIT2 = 4, NSPLIT4 = 8;
constexpr size_t WS_PART2 = WS_BIG  , WS_PART4 = WS_MIX  ;
constexpr int CW_BAR = 4096;

__device__ __forceinline__ float bflo(unsigned w) { return __uint_as_float(w << 16); }
__device__ __forceinline__ float bfhi(unsigned w) { return __uint_as_float(w & 0xffff0000u); }
__device__ __forceinline__ float bf1(bf16 h) { return __uint_as_float(((unsigned)h) << 16); }
__device__ __forceinline__ unsigned pk(float lo, float hi) { return pg8::cvt_pk_bf16(lo, hi); }
__device__ __forceinline__ bf16 tobf(float x) { return (bf16)(pg8::cvt_pk_bf16(x, 0.f) & 0xffffu); }
__device__ __forceinline__ float silu_f(float x) { return x / (1.f + __expf(-x)); }
__device__ __forceinline__ float wave_sum(float v) {
#pragma unroll
    for (int o = 1; o < 64; o <<= 1) v += __shfl_xor(v, o);
    return v;
}
#define MFMA16(a, b, c) __builtin_amdgcn_mfma_f32_16x16x32_bf16((a), (b), (c), 0, 0, 0)

struct EpiProj {
    static constexpr bool PERM = true, AFTER_DRAIN = false;
    bf16 *QB, *VB, *GB, *BB, *UB; float* LF; const float* lbl; int layer;
    __device__ __forceinline__ void operator()(const f32x4 (&acc)[2][2][4][2], const pg8::Unit& u, int wr, int wc, int fr, int fq) const {
        const int row0 = u.pm * 256 + wr * 64 + fr, cw = wc * 32 + 8 * fq;
        if (u.pn >= 10) {
            const int col = (u.pn - 10) * 128 + cw;
#pragma unroll
            for (int ai = 0; ai < 2; ++ai)
#pragma unroll
                for (int m = 0; m < 4; ++m) {
                    const f32x4 v0 = acc[ai][0][m][0] * acc[ai][1][m][0], v1 = acc[ai][0][m][1] * acc[ai][1][m][1];
                    u32x4 w; w.x = pk(v0[0], v0[1]); w.y = pk(v0[2], v0[3]); w.z = pk(v1[0], v1[1]); w.w = pk(v1[2], v1[3]);
                    *(u32x4*)(UB + (size_t)(row0 + ai * 128 + m * 16) * HW + col) = w;
                }
        } else {
            const int blk = u.pn >> 1, cb = (u.pn & 1) * 256 + cw;
            if (blk == 1) {
                f32x4 lb[2][2];
#pragma unroll
                for (int bj = 0; bj < 2; ++bj)
#pragma unroll
                    for (int n = 0; n < 2; ++n)
#pragma unroll
                        for (int e = 0; e < 4; ++e) { const int col = cb + bj * 128 + 4 * n + e; lb[bj][n][e] = (layer == 0) ? 0.f : 1.f / (1.f + __expf(lbl[col] - lbl[HW + col])); }
#pragma unroll
                for (int ai = 0; ai < 2; ++ai)
#pragma unroll
                    for (int m = 0; m < 4; ++m)
#pragma unroll
                        for (int bj = 0; bj < 2; ++bj) {
                            float* dst = LF + (size_t)(row0 + ai * 128 + m * 16) * HW + cb + bj * 128;
#pragma unroll
                            for (int n = 0; n < 2; ++n) {
                                f32x4 o;
#pragma unroll
                                for (int e = 0; e < 4; ++e) {
                                    const float z = acc[ai][bj][m][n][e], l = lb[bj][n][e];
                                    const float ls = fminf(z, 0.f) - __logf(1.f + __expf(-fabsf(z)));
                                    o[e] = (l > 0.f) ? __logf(l + (1.f - l) * __expf(ls)) : ls;
                                }
                                *(f32x4*)(dst + 4 * n) = o;
                            }
                        }
            } else {
                bf16* dst0 = (blk == 0) ? QB : (blk == 2) ? VB : (blk == 3) ? GB : BB;
                const bool act = (blk == 0) || (blk == 3);
#pragma unroll
                for (int ai = 0; ai < 2; ++ai)
#pragma unroll
                    for (int m = 0; m < 4; ++m)
#pragma unroll
                        for (int bj = 0; bj < 2; ++bj) {
                            f32x4 v0 = acc[ai][bj][m][0], v1 = acc[ai][bj][m][1];
                            if (act) {
#pragma unroll
                                for (int e = 0; e < 4; ++e) { v0[e] = silu_f(v0[e]); v1[e] = silu_f(v1[e]); }
                            }
                            u32x4 w; w.x = pk(v0[0], v0[1]); w.y = pk(v0[2], v0[3]); w.z = pk(v1[0], v1[1]); w.w = pk(v1[2], v1[3]);
                            *(u32x4*)(dst0 + (size_t)(row0 + ai * 128 + m * 16) * HW + cb + bj * 128) = w;
                        }
            }
        }
    }
};
struct EpiRes {
    static constexpr bool PERM = true, AFTER_DRAIN = false;
    const bf16* res; bf16* out;
    __device__ __forceinline__ void operator()(const f32x4 (&acc)[2][2][4][2], const pg8::Unit& u, int wr, int wc, int fr, int fq) const {
        const int row0 = u.pm * 256 + wr * 64 + fr, c0 = u.pn * 256 + wc * 32 + 8 * fq;
#pragma unroll
        for (int ai = 0; ai < 2; ++ai)
#pragma unroll
            for (int m = 0; m < 4; ++m)
#pragma unroll
                for (int bj = 0; bj < 2; ++bj) {
                    const size_t off = (size_t)(row0 + ai * 128 + m * 16) * DM + c0 + bj * 128;
                    const u32x4 r = *(const u32x4*)(res + off);
                    const f32x4 a0 = acc[ai][bj][m][0], a1 = acc[ai][bj][m][1];
                    u32x4 w;
                    w.x = pk(a0[0] + ALPHA * bflo(r.x), a0[1] + ALPHA * bfhi(r.x)); w.y = pk(a0[2] + ALPHA * bflo(r.y), a0[3] + ALPHA * bfhi(r.y));
                    w.z = pk(a1[0] + ALPHA * bflo(r.z), a1[1] + ALPHA * bfhi(r.z)); w.w = pk(a1[2] + ALPHA * bflo(r.w), a1[3] + ALPHA * bfhi(r.w));
                    *(u32x4*)(out + off) = w;
                }
    }
};
struct EpiRelu2 {
    static constexpr bool PERM = true, AFTER_DRAIN = false;
    bf16* out;
    __device__ __forceinline__ void operator()(const f32x4 (&acc)[2][2][4][2], const pg8::Unit& u, int wr, int wc, int fr, int fq) const {
        const int row0 = u.pm * 256 + wr * 64 + fr, c0 = u.pn * 256 + wc * 32 + 8 * fq;
#pragma unroll
        for (int ai = 0; ai < 2; ++ai)
#pragma unroll
            for (int m = 0; m < 4; ++m)
#pragma unroll
                for (int bj = 0; bj < 2; ++bj) {
                    f32x4 a0 = acc[ai][bj][m][0], a1 = acc[ai][bj][m][1];
#pragma unroll
                    for (int e = 0; e < 4; ++e) { const float x = fmaxf(a0[e], 0.f), y = fmaxf(a1[e], 0.f); a0[e] = x * x; a1[e] = y * y; }
                    u32x4 w; w.x = pk(a0[0], a0[1]); w.y = pk(a0[2], a0[3]); w.z = pk(a1[0], a1[1]); w.w = pk(a1[2], a1[3]);
                    *(u32x4*)(out + (size_t)(row0 + ai * 128 + m * 16) * FF + c0 + bj * 128) = w;
                }
    }
};

struct EpiPart {
    static constexpr bool PERM = true, AFTER_DRAIN = false;
    float* part; const bf16* res;
    __device__ __forceinline__ void operator()(const f32x4 (&acc)[2][2][4][2], const pg8::Unit& u, int wr, int wc, int fr, int fq) const {
        const int row0 = u.pm * 256 + wr * 64 + fr - TP, c0 = u.pn * 256 + wc * 32 + 8 * fq;
        float* base = part + (size_t)u.ks * TS * DM;
#pragma unroll
        for (int ai = 0; ai < 2; ++ai)
#pragma unroll
            for (int m = 0; m < 4; ++m)
#pragma unroll
                for (int bj = 0; bj < 2; ++bj) {
                    float* d = base + (size_t)(row0 + ai * 128 + m * 16) * DM + c0 + bj * 128;
                    f32x4 a0 = acc[ai][bj][m][0], a1 = acc[ai][bj][m][1];
                    if (u.ks == 0) { const u32x4 r = *(const u32x4*)(res + (size_t)(row0 + TP + ai * 128 + m * 16) * DM + c0 + bj * 128);
                        a0[0] += ALPHA * bflo(r.x); a0[1] += ALPHA * bfhi(r.x); a0[2] += ALPHA * bflo(r.y); a0[3] += ALPHA * bfhi(r.y);
                        a1[0] += ALPHA * bflo(r.z); a1[1] += ALPHA * bfhi(r.z); a1[2] += ALPHA * bflo(r.w); a1[3] += ALPHA * bfhi(r.w); }
                    *(f32x4*)d = a0; *(f32x4*)(d + 4) = a1;
                }
    }
};

__device__ __forceinline__ int remap_in(int n0) {
    if (n0 < 2560) return n0;
    if (n0 < 3072) { const int c = n0 - 2560; return 2560 + 256 * (c >> 7) + (c & 127); }
    const int c = n0 - 3072; return 2560 + 256 * (c >> 7) + 128 + (c & 127);
}
__device__ __forceinline__ void transpose_item(const float* W, int K, int N, bf16* WT, bool remap, LAS float* scr, int item, int lane) {
    const int nblk = N / 32, kb = item / nblk, nb = item % nblk, k0 = 64 * kb, n0 = 32 * nb;
    const int d0 = remap ? remap_in(n0) : n0;
#pragma unroll 8
    for (int i = 0; i < 32; ++i) { const int kk = 2 * i + (lane >> 5); scr[kk * 33 + (lane & 31)] = W[(size_t)(k0 + kk) * N + n0 + (lane & 31)]; }
    asm volatile("s_waitcnt lgkmcnt(0)" ::: "memory");
    const int c = lane & 7;
#pragma unroll
    for (int j = 0; j < 4; ++j) { const int n = (lane >> 3) + 8 * j; const LAS float* s = scr + (8 * c) * 33 + n;
        u32x4 o; o.x = pk(s[0 * 33], s[1 * 33]); o.y = pk(s[2 * 33], s[3 * 33]); o.z = pk(s[4 * 33], s[5 * 33]); o.w = pk(s[6 * 33], s[7 * 33]);
        *(u32x4*)(WT + (size_t)(d0 + n) * K + k0 + 8 * c) = o; }
    asm volatile("s_waitcnt lgkmcnt(0)" ::: "memory");
}
__device__ __forceinline__ void p0_phase(ldsp lds, const float* const* in, unsigned char* ws, int gw, int ngw, int wave, int lane) {
    LAS float* scr = (LAS float*)(lds + wave * 16384);
    constexpr int I_IN = 16 * 112, I_OUT = 16 * 32, I_F1 = 16 * 128, I_F2 = 64 * 32, I_L = I_IN + I_OUT + I_F1 + I_F2;
    for (int it = gw; it < 2 * I_L; it += ngw) {
        const int l = it / I_L; int r = it % I_L;
        unsigned char* wl = ws + WS_W + (size_t)l * W_LAYER;
        if (r < I_IN) { transpose_item(in[4] + (size_t)l * DM * PW, DM, PW, (bf16*)(wl + W_IN), true, scr, r, lane); continue; } r -= I_IN;
        if (r < I_OUT) { transpose_item(in[8] + (size_t)l * DM * DM, DM, DM, (bf16*)(wl + W_OUT), false, scr, r, lane); continue; } r -= I_OUT;
        if (r < I_F1) { transpose_item(in[11] + (size_t)l * DM * FF, DM, FF, (bf16*)(wl + W_FF1), false, scr, r, lane); continue; } r -= I_F1;
        transpose_item(in[12] + (size_t)l * FF * DM, FF, DM, (bf16*)(wl + W_FF2), false, scr, r, lane);
    }
    bf16* XB = (bf16*)(ws + WS_XB);
    for (int r = gw; r < TT; r += ngw) {
        const float* src = (r < TP) ? in[0] + (size_t)r * DM : in[1] + (size_t)(r - TP) * DM;
#pragma unroll
        for (int j = 0; j < 4; ++j) { const f32x4 v = *(const f32x4*)(src + 4 * lane + 256 * j); u32x2 w; w.x = pk(v[0], v[1]); w.y = pk(v[2], v[3]); *(u32x2*)(XB + (size_t)r * DM + 4 * lane + 256 * j) = w; }
    }
}

constexpr int L_BS = 0, L_QS = 32768, L_KS = 50176, L_KT = 32768, L_VT = 67584, L_ST = 86016, L_PP = 120832, L_SEG = 130048, L_RED = 132096;
constexpr int RS128 = 272, RS64 = 144;

__device__ __forceinline__ void load_cumsum(ldsp lds, const float* LF, int tok0, int h, float (&kk)[16], int tid) {
    LAS float* BS = (LAS float*)(lds + L_BS); LAS float* SEG = (LAS float*)(lds + L_SEG);
#pragma unroll
    for (int j = 0; j < 4; ++j) { const int idx = tid + 512 * j, t = idx >> 5, c4 = idx & 31;
        *(LAS f32x4*)(BS + t * 128 + 4 * c4) = *(const f32x4*)(LF + (size_t)(tok0 + t) * HW + h * 128 + 4 * c4); }
    __syncthreads();
    const int c = tid & 127, sg = tid >> 7;
    float run = 0.f;
#pragma unroll
    for (int i = 0; i < 16; ++i) { const int t = sg * 16 + i; const float lf = BS[t * 128 + c]; kk[i] = -expm1f(lf); run += lf; BS[t * 128 + c] = run; }
    SEG[sg * 128 + c] = run;
    __syncthreads();
    float off = 0.f;
    for (int s = 0; s < sg; ++s) off += SEG[s * 128 + c];
#pragma unroll
    for (int i = 0; i < 16; ++i) BS[(sg * 16 + i) * 128 + c] += off;
    __syncthreads();
}
__device__ __forceinline__ void load_vt(ldsp lds, const bf16* VB, int tok0, int h, int tid) {
    const int c2 = tid & 63, sgp = tid >> 6;
    unsigned w[8];
#pragma unroll
    for (int e = 0; e < 8; ++e) w[e] = *(const unsigned*)(VB + (size_t)(tok0 + 8 * sgp + e) * HW + h * 128 + 2 * c2);
    u32x4 lo, hi;
    lo.x = (w[0] & 0xffffu) | (w[1] << 16); lo.y = (w[2] & 0xffffu) | (w[3] << 16); lo.z = (w[4] & 0xffffu) | (w[5] << 16); lo.w = (w[6] & 0xffffu) | (w[7] << 16);
    hi.x = (w[0] >> 16) | (w[1] & 0xffff0000u); hi.y = (w[2] >> 16) | (w[3] & 0xffff0000u); hi.z = (w[4] >> 16) | (w[5] & 0xffff0000u); hi.w = (w[6] >> 16) | (w[7] & 0xffff0000u);
    *(LAS u32x4*)(lds + L_VT + (2 * c2) * RS64 + 16 * sgp) = lo;
    *(LAS u32x4*)(lds + L_VT + (2 * c2 + 1) * RS64 + 16 * sgp) = hi;
}

__device__ __forceinline__ void h1_prompt_unit(ldsp lds, int unit, const float* LF, const bf16* VB, float* Lbuf, float* DEC, int tid, int wave, int lane) {
    const int bh = unit >> 5, n = unit & 31, b = bh >> 2, h = bh & 3, tok0 = b * SEQ + n * 64;
    float kk[16];
    load_cumsum(lds, LF, tok0, h, kk, tid);
    LAS float* BS = (LAS float*)(lds + L_BS);
    const int c = tid & 127, sg = tid >> 7;
    const float blast = BS[63 * 128 + c];
#pragma unroll
    for (int hf = 0; hf < 2; ++hf) {
        float kd[8];
#pragma unroll
        for (int e = 0; e < 8; ++e) { const int i = hf * 8 + e; kd[e] = kk[i] * __expf(blast - BS[(sg * 16 + i) * 128 + c]); }
        u32x4 w; w.x = pk(kd[0], kd[1]); w.y = pk(kd[2], kd[3]); w.z = pk(kd[4], kd[5]); w.w = pk(kd[6], kd[7]);
        *(LAS u32x4*)(lds + L_KT + c * RS64 + (sg * 16 + hf * 8) * 2) = w;
    }
    if (sg == 0) DEC[unit * 128 + c] = __expf(blast);
    load_vt(lds, VB, tok0, h, tid);
    __syncthreads();
    const int fr = lane & 15, fq = lane >> 4;
    bf16x8 bk[2];
#pragma unroll
    for (int k2 = 0; k2 < 2; ++k2) bk[k2] = *(const LAS bf16x8*)(lds + L_KT + (16 * wave + fr) * RS64 + (32 * k2 + 8 * fq) * 2);
    float* Lu = Lbuf + (size_t)unit * 16384;
#pragma unroll
    for (int mt = 0; mt < 8; ++mt) {
        f32x4 acc = {0.f, 0.f, 0.f, 0.f};
#pragma unroll
        for (int k2 = 0; k2 < 2; ++k2) { const bf16x8 a = *(const LAS bf16x8*)(lds + L_VT + (16 * mt + fr) * RS64 + (32 * k2 + 8 * fq) * 2); acc = MFMA16(a, bk[k2], acc); }
        *(f32x4*)(Lu + (16 * wave + fr) * 128 + 16 * mt + 4 * fq) = acc;
    }
}

__device__ __forceinline__ void h_sample_unit(ldsp lds, int su, int layer, const float* LF, const bf16* QB, const bf16* VB, const bf16* GB, const float* state_hgrn, const float* onorm,
                                              bf16* MIX, float* out, int tid, int wave, int lane) {
    const int b = su >> 2, h = su & 3, R0 = TP + b * 8;
    LAS float* bs = (LAS float*)(lds + 0); LAS float* kkS = (LAS float*)(lds + 4096); LAS float* qq = (LAS float*)(lds + 8192); LAS float* aq = (LAS float*)(lds + 12288);
    LAS float* kd = (LAS float*)(lds + 16384); LAS float* vv = (LAS float*)(lds + 20480); LAS float* sc = (LAS float*)(lds + 24576); LAS float* part = (LAS float*)(lds + 32768);
    {
        const int c = tid & 127, p = tid >> 7;
        if (p == 0) {
            float run = 0.f;
#pragma unroll
            for (int t = 0; t < 8; ++t) { const float lf = LF[(size_t)(R0 + t) * HW + h * 128 + c]; kkS[t * 128 + c] = -expm1f(lf); run += lf; bs[t * 128 + c] = run; }
#pragma unroll
            for (int t = 0; t < 8; ++t) { const float bt = bs[t * 128 + c]; const float q = bf1(QB[(size_t)(R0 + t) * HW + h * 128 + c]);
                qq[t * 128 + c] = q; aq[t * 128 + c] = q * __expf(bt); kd[t * 128 + c] = kkS[t * 128 + c] * __expf(run - bt); }
        } else if (p == 1) {
#pragma unroll
            for (int t = 0; t < 8; ++t) vv[t * 128 + c] = bf1(VB[(size_t)(R0 + t) * HW + h * 128 + c]);
        }
    }
    __syncthreads();
    {
        const int pair = tid >> 3, t = pair >> 3, s = pair & 7, sub = tid & 7;
        float sum = 0.f;
        if (s <= t) {
#pragma unroll
            for (int e = 0; e < 16; ++e) { const int c = sub * 16 + e; sum += qq[t * 128 + c] * __expf(bs[t * 128 + c] - bs[s * 128 + c]) * kkS[s * 128 + c]; }
        }
        sum += __shfl_xor(sum, 1); sum += __shfl_xor(sum, 2); sum += __shfl_xor(sum, 4);
        if (sub == 0) sc[t * 8 + s] = sum;
    }
    __syncthreads();
    {
        const int v4 = tid & 31, kg = tid >> 5;
        const size_t so = (((size_t)layer * 128 + b) * 4 + h) * 16384;
        const float* S0 = state_hgrn + so; float* SN = out + O_HS + so;
        f32x4 op[8];
#pragma unroll
        for (int t = 0; t < 8; ++t) op[t] = (f32x4){0.f, 0.f, 0.f, 0.f};
#pragma unroll
        for (int i = 0; i < 8; ++i) {
            const int k = 8 * kg + i;
            const f32x4 s0 = *(const f32x4*)(S0 + k * 128 + 4 * v4);
#pragma unroll
            for (int t = 0; t < 8; ++t) op[t] += aq[t * 128 + k] * s0;
            f32x4 sn = s0 * __expf(bs[7 * 128 + k]);
#pragma unroll
            for (int s = 0; s < 8; ++s) sn += kd[s * 128 + k] * (*(const LAS f32x4*)(vv + s * 128 + 4 * v4));
            *(f32x4*)(SN + k * 128 + 4 * v4) = sn;
        }
#pragma unroll
        for (int t = 0; t < 8; ++t) {
#pragma unroll
            for (int e = 0; e < 4; ++e) op[t][e] += __shfl_xor(op[t][e], 32);
            if (lane < 32) *(LAS f32x4*)(part + (wave * 8 + t) * 128 + 4 * v4) = op[t];
        }
    }
    __syncthreads();
    {
        const int t = wave, v = 2 * lane;
        float o0 = 0.f, o1 = 0.f;
#pragma unroll
        for (int w = 0; w < 8; ++w) { o0 += part[(w * 8 + t) * 128 + v]; o1 += part[(w * 8 + t) * 128 + v + 1]; }
        for (int s = 0; s <= t; ++s) { const float p = sc[t * 8 + s]; o0 += p * vv[s * 128 + v]; o1 += p * vv[s * 128 + v + 1]; }
        const float rstd = rsqrtf(wave_sum(o0 * o0 + o1 * o1) * (1.f / 128.f) + RMS_EPS);
        const unsigned g = *(const unsigned*)(GB + (size_t)(R0 + t) * HW + h * 128 + v);
        const float on0 = onorm[layer * HW + h * 128 + v], on1 = onorm[layer * HW + h * 128 + v + 1];
        *(unsigned*)(MIX + (size_t)(R0 + t) * DM + h * 128 + v) = pk(o0 * rstd * on0 * bflo(g), o1 * rstd * on1 * bfhi(g));
    }
}

__device__ __forceinline__ void h3_prompt_unit(ldsp lds, int unit, int layer, const float* LF, const bf16* QB, const bf16* VB, const bf16* GB, const float* Sbuf, const float* onorm,
                                               bf16* MIX, int tid, int wave, int lane) {
    const int bh = unit >> 5, n = unit & 31, b = bh >> 2, h = bh & 3, tok0 = b * SEQ + n * 64;
    float kk[16];
    load_cumsum(lds, LF, tok0, h, kk, tid);
    LAS float* BS = (LAS float*)(lds + L_BS);
    {
        const int c = tid & 127, sg = tid >> 7;
        const float bref = BS[31 * 128 + c];
#pragma unroll
        for (int i = 0; i < 16; ++i) {
            const int t = sg * 16 + i; const float bt = BS[t * 128 + c];
            const float q = bf1(QB[(size_t)(tok0 + t) * HW + h * 128 + c]);
            *(LAS bf16*)(lds + L_QS + t * RS128 + 2 * c) = tobf(q * __expf(fminf(bt - bref, 80.f)));
            *(LAS bf16*)(lds + L_KS + t * RS128 + 2 * c) = tobf(kk[i] * __expf(fminf(bref - bt, 80.f)));
        }
    }
    load_vt(lds, VB, tok0, h, tid);
    {
        const int v = tid & 127, kg = tid >> 7;
        const float* Su = Sbuf + (size_t)unit * 16384;
#pragma unroll
        for (int i8 = 0; i8 < 4; ++i8) {
            const int k0 = 32 * kg + 8 * i8;
            float s[8];
#pragma unroll
            for (int e = 0; e < 8; ++e) s[e] = Su[(k0 + e) * 128 + v] * __expf(BS[31 * 128 + k0 + e]);
            u32x4 w; w.x = pk(s[0], s[1]); w.y = pk(s[2], s[3]); w.z = pk(s[4], s[5]); w.w = pk(s[6], s[7]);
            *(LAS u32x4*)(lds + L_ST + v * RS128 + k0 * 2) = w;
        }
    }
    __syncthreads();
    const int fr = lane & 15, fq = lane >> 4, tm = wave >> 1;
    {
        const int ts0 = (wave & 1) * 2;
        f32x4 sc[2] = {{0.f, 0.f, 0.f, 0.f}, {0.f, 0.f, 0.f, 0.f}};
#pragma unroll
        for (int k2 = 0; k2 < 4; ++k2) {
            const bf16x8 a = *(const LAS bf16x8*)(lds + L_QS + (16 * tm + fr) * RS128 + (32 * k2 + 8 * fq) * 2);
#pragma unroll
            for (int i = 0; i < 2; ++i) { const bf16x8 bb = *(const LAS bf16x8*)(lds + L_KS + (16 * (ts0 + i) + fr) * RS128 + (32 * k2 + 8 * fq) * 2); sc[i] = MFMA16(a, bb, sc[i]); }
        }
#pragma unroll
        for (int i = 0; i < 2; ++i)
#pragma unroll
            for (int j = 0; j < 4; ++j) { const int t = 16 * tm + 4 * fq + j, s = 16 * (ts0 + i) + fr;
                *(LAS bf16*)(lds + L_PP + t * RS64 + 2 * s) = tobf((s <= t) ? sc[i][j] : 0.f); }
    }
    __syncthreads();
    const int vh = wave & 1;
    f32x4 o[4];
#pragma unroll
    for (int i = 0; i < 4; ++i) o[i] = (f32x4){0.f, 0.f, 0.f, 0.f};
#pragma unroll
    for (int k2 = 0; k2 < 4; ++k2) {
        const bf16x8 bq = *(const LAS bf16x8*)(lds + L_QS + (16 * tm + fr) * RS128 + (32 * k2 + 8 * fq) * 2);
#pragma unroll
        for (int i = 0; i < 4; ++i) { const bf16x8 a = *(const LAS bf16x8*)(lds + L_ST + (16 * (4 * vh + i) + fr) * RS128 + (32 * k2 + 8 * fq) * 2); o[i] = MFMA16(a, bq, o[i]); }
    }
#pragma unroll
    for (int k2 = 0; k2 < 2; ++k2) {
        const bf16x8 bp = *(const LAS bf16x8*)(lds + L_PP + (16 * tm + fr) * RS64 + (32 * k2 + 8 * fq) * 2);
#pragma unroll
        for (int i = 0; i < 4; ++i) { const bf16x8 a = *(const LAS bf16x8*)(lds + L_VT + (16 * (4 * vh + i) + fr) * RS64 + (32 * k2 + 8 * fq) * 2); o[i] = MFMA16(a, bp, o[i]); }
    }
    float ss = 0.f;
#pragma unroll
    for (int i = 0; i < 4; ++i) ss += (o[i][0] * o[i][0] + o[i][1] * o[i][1]) + (o[i][2] * o[i][2] + o[i][3] * o[i][3]);
    ss += __shfl_xor(ss, 16); ss += __shfl_xor(ss, 32);
    LAS float* RED = (LAS float*)(lds + L_RED);
    if (fq == 0) RED[vh * 64 + 16 * tm + fr] = ss;
    __syncthreads();
    const float rstd = rsqrtf((RED[16 * tm + fr] + RED[64 + 16 * tm + fr]) * (1.f / 128.f) + RMS_EPS);
    const size_t row = (size_t)(tok0 + 16 * tm + fr);
#pragma unroll
    for (int i = 0; i < 4; ++i) {
        const int vc = h * 128 + 16 * (4 * vh + i) + 4 * fq;
        const u32x2 g = *(const u32x2*)(GB + row * HW + vc);
        const f32x4 on = *(const f32x4*)(onorm + layer * HW + vc);
        u32x2 w; w.x = pk(o[i][0] * rstd * on[0] * bflo(g.x), o[i][1] * rstd * on[1] * bfhi(g.x)); w.y = pk(o[i][2] * rstd * on[2] * bflo(g.y), o[i][3] * rstd * on[3] * bfhi(g.y));
        *(u32x2*)(MIX + row * DM + vc) = w;
    }
}

__device__ __forceinline__ void h2_phase(int layer, float* Lbuf, const float* DEC, float* out, const bf16* UB, const bf16* BB, const float* state_conv, const float* conv_w, bf16* MIX, int gtid, int ngt) {
    for (int g = gtid; g < 32 * 4096; g += ngt) {
        const int bh = g >> 12, k = (g >> 5) & 127, v4 = g & 31;
        f32x4 S = {0.f, 0.f, 0.f, 0.f};
        float* Lp = Lbuf + (size_t)bh * 32 * 16384 + k * 128 + 4 * v4;
        const float* dp = DEC + bh * 32 * 128 + k;
        f32x4 l0[8], l1[8]; float d0[8], d1[8];
#pragma unroll
        for (int j = 0; j < 8; ++j) { l0[j] = *(const f32x4*)(Lp + (size_t)j * 16384); d0[j] = dp[j * 128]; }
#pragma unroll
        for (int n0 = 0; n0 < NCHUNK; n0 += 16) {
#pragma unroll
            for (int j = 0; j < 8; ++j) { l1[j] = *(const f32x4*)(Lp + (size_t)(n0 + 8 + j) * 16384); d1[j] = dp[(n0 + 8 + j) * 128]; }
#pragma unroll
            for (int j = 0; j < 8; ++j) { *(f32x4*)(Lp + (size_t)(n0 + j) * 16384) = S; S = S * d0[j] + l0[j]; }
            if (n0 + 16 < NCHUNK) {
#pragma unroll
                for (int j = 0; j < 8; ++j) { l0[j] = *(const f32x4*)(Lp + (size_t)(n0 + 16 + j) * 16384); d0[j] = dp[(n0 + 16 + j) * 128]; }
            }
#pragma unroll
            for (int j = 0; j < 8; ++j) { *(f32x4*)(Lp + (size_t)(n0 + 8 + j) * 16384) = S; S = S * d1[j] + l1[j]; }
        }
        *(f32x4*)(out + O_HP + ((size_t)layer * 32 + bh) * 16384 + k * 128 + 4 * v4) = S;
    }
    for (int g = gtid; g < TT * 64; g += ngt) {
        const int r = g >> 6, c = (g & 63) * 8;
        int t, bsm = -1, row0;
        if (r < TP) { t = r & (SEQ - 1); row0 = r - t; } else { const int q = r - TP; t = q & 7; bsm = q >> 3; row0 = r - t; }
        float u0[8], u1[8], u2[8];
        { const u32x4 w = *(const u32x4*)(UB + (size_t)r * HW + c); u2[0] = bflo(w.x); u2[1] = bfhi(w.x); u2[2] = bflo(w.y); u2[3] = bfhi(w.y); u2[4] = bflo(w.z); u2[5] = bfhi(w.z); u2[6] = bflo(w.w); u2[7] = bfhi(w.w); }
        if (t >= 1) { const u32x4 w = *(const u32x4*)(UB + (size_t)(r - 1) * HW + c); u1[0] = bflo(w.x); u1[1] = bfhi(w.x); u1[2] = bflo(w.y); u1[3] = bfhi(w.y); u1[4] = bflo(w.z); u1[5] = bfhi(w.z); u1[6] = bflo(w.w); u1[7] = bfhi(w.w); }
        else {
#pragma unroll
            for (int e = 0; e < 8; ++e) u1[e] = (bsm >= 0) ? state_conv[(((size_t)layer * 128 + bsm) * 2 + 1) * HW + c + e] : 0.f;
        }
        if (t >= 2) { const u32x4 w = *(const u32x4*)(UB + (size_t)(r - 2) * HW + c); u0[0] = bflo(w.x); u0[1] = bfhi(w.x); u0[2] = bflo(w.y); u0[3] = bfhi(w.y); u0[4] = bflo(w.z); u0[5] = bfhi(w.z); u0[6] = bflo(w.w); u0[7] = bfhi(w.w); }
        else {
#pragma unroll
            for (int e = 0; e < 8; ++e) u0[e] = (bsm >= 0) ? state_conv[(((size_t)layer * 128 + bsm) * 2 + t) * HW + c + e] : 0.f;
        }
        const u32x4 gb = *(const u32x4*)(BB + (size_t)r * HW + c);
        float gv[8] = {bflo(gb.x), bfhi(gb.x), bflo(gb.y), bfhi(gb.y), bflo(gb.z), bfhi(gb.z), bflo(gb.w), bfhi(gb.w)};
        float y[8];
#pragma unroll
        for (int e = 0; e < 8; ++e) { const float w0 = conv_w[(layer * 3 + 0) * HW + c + e], w1 = conv_w[(layer * 3 + 1) * HW + c + e], w2 = conv_w[(layer * 3 + 2) * HW + c + e];
            y[e] = gv[e] * (w0 * u0[e] + w1 * u1[e] + w2 * u2[e]); }
        u32x4 w; w.x = pk(y[0], y[1]); w.y = pk(y[2], y[3]); w.z = pk(y[4], y[5]); w.w = pk(y[6], y[7]);
        *(u32x4*)(MIX + (size_t)r * DM + HW + c) = w;
        (void)row0;
        if (bsm < 0) { if (t >= SEQ - 2) { float* d = out + O_CP + (((size_t)layer * 8 + (r >> 11)) * 2 + (t - (SEQ - 2))) * HW + c;
#pragma unroll
                for (int e = 0; e < 8; ++e) d[e] = u2[e]; } }
        else { if (t >= 6) { float* d = out + O_CS + (((size_t)layer * 128 + bsm) * 2 + (t - 6)) * HW + c;
#pragma unroll
                for (int e = 0; e < 8; ++e) d[e] = u2[e]; } }
    }
}

__device__ __forceinline__ void ln_phase(bf16* X, const float* part, int nsplit, const float* g, const float* bta, float* yout, int gw, int ngw, int lane) {
    for (int r = gw; r < TT; r += ngw) {
        bf16* xr = X + (size_t)r * DM;
        float v[16];
        if (r < TP) {
            const u32x4 a0 = *(const u32x4*)(xr + 8 * lane), a1 = *(const u32x4*)(xr + 512 + 8 * lane);
            v[0] = bflo(a0.x); v[1] = bfhi(a0.x); v[2] = bflo(a0.y); v[3] = bfhi(a0.y); v[4] = bflo(a0.z); v[5] = bfhi(a0.z); v[6] = bflo(a0.w); v[7] = bfhi(a0.w);
            v[8] = bflo(a1.x); v[9] = bfhi(a1.x); v[10] = bflo(a1.y); v[11] = bfhi(a1.y); v[12] = bflo(a1.z); v[13] = bfhi(a1.z); v[14] = bflo(a1.w); v[15] = bfhi(a1.w);
        } else {
#pragma unroll
            for (int e = 0; e < 16; ++e) v[e] = 0.f;
            for (int s = 0; s < nsplit; ++s) {
                const float* pp = part + ((size_t)s * TS + (r - TP)) * DM;
#pragma unroll
                for (int hf = 0; hf < 2; ++hf) { const f32x4 p0 = *(const f32x4*)(pp + hf * 512 + 8 * lane), p1 = *(const f32x4*)(pp + hf * 512 + 8 * lane + 4);
#pragma unroll
                    for (int e = 0; e < 4; ++e) { v[hf * 8 + e] += p0[e]; v[hf * 8 + 4 + e] += p1[e]; } }
            }
        }
        float s = 0.f;
#pragma unroll
        for (int e = 0; e < 16; ++e) s += v[e];
        const float mean = wave_sum(s) * (1.f / DM);
        float s2 = 0.f;
#pragma unroll
        for (int e = 0; e < 16; ++e) { v[e] -= mean; s2 += v[e] * v[e]; }
        const float rstd = rsqrtf(wave_sum(s2) * (1.f / DM) + LN_EPS);
#pragma unroll
        for (int hf = 0; hf < 2; ++hf) {
            const int c = hf * 512 + 8 * lane;
            const f32x4 g0 = *(const f32x4*)(g + c), g1 = *(const f32x4*)(g + c + 4), b0 = *(const f32x4*)(bta + c), b1 = *(const f32x4*)(bta + c + 4);
            f32x4 y0, y1;
#pragma unroll
            for (int e = 0; e < 4; ++e) { y0[e] = v[hf * 8 + e] * rstd * g0[e] + b0[e]; y1[e] = v[hf * 8 + 4 + e] * rstd * g1[e] + b1[e]; }
            u32x4 w; w.x = pk(y0[0], y0[1]); w.y = pk(y0[2], y0[3]); w.z = pk(y1[0], y1[1]); w.w = pk(y1[2], y1[3]);
            *(u32x4*)(xr + c) = w;
            if (yout) { *(f32x4*)(yout + (size_t)r * DM + c) = y0; *(f32x4*)(yout + (size_t)r * DM + c + 4) = y1; }
        }
    }
}

#define RLX_AGENT __ATOMIC_RELAXED, __HIP_MEMORY_SCOPE_AGENT
#define XB_TMO      128
#define XB_XCNT(j)  (256  + 64 * (j))
#define XB_XSUB(j)  (1280 + 64 * (j))
#define XB_XGEN(j)  (2304 + 64 * (j))
#define XB_TOP      3328
#define XB_TOPGEN   3392
#define XCD_BAR_WORDS 3456
#define XB_SPIN_CAP (1u << 18)

__device__ __forceinline__ unsigned xb_ld(unsigned* p)              { return __hip_atomic_load(p, __ATOMIC_RELAXED, __HIP_MEMORY_SCOPE_AGENT); }
__device__ __forceinline__ unsigned xb_add(unsigned* p, unsigned v) { return __hip_atomic_fetch_add(p, v, __ATOMIC_RELAXED, __HIP_MEMORY_SCOPE_AGENT); }
__device__ __forceinline__ unsigned xb_xcc_id() { return (unsigned)__builtin_amdgcn_s_getreg((3 << 11) | 20) & 0xFu; }
#define XB_SPIN(cond, bar) do { unsigned _sp = 0; while (cond) { __builtin_amdgcn_s_sleep(1); \
    if ((++_sp & 255u) == 0u) { if (xb_ld(&(bar)[XB_TMO])) break; if (_sp > XB_SPIN_CAP) { atomicAdd(&(bar)[XB_TMO], 1u); break; } } } } while (0)

struct XcdBarrier {
    unsigned* bar; unsigned x;
    volatile LAS unsigned* st;
};

__device__ __forceinline__ XcdBarrier xcd_barrier_post(unsigned* bar, volatile LAS unsigned* st) {
    XcdBarrier b; b.bar = bar; b.x = xb_xcc_id(); b.st = st;
    if (threadIdx.x == 0) (void)xb_add(&bar[XB_XCNT(b.x)], 1u);
    return b;
}
__device__ __forceinline__ void xcd_barrier_complete(unsigned* bar, unsigned x, unsigned& nloc, unsigned& nx) {
    const unsigned G = gridDim.x * gridDim.y * gridDim.z;
    unsigned sum, cnt, mine, sp = 0u;
    for (;;) {
        sum = 0u; cnt = 0u; mine = 0u;
#pragma unroll
        for (unsigned j = 0; j < 16; ++j) { const unsigned c = xb_ld(&bar[XB_XCNT(j)]); sum += c; cnt += (c > 0u) ? 1u : 0u; mine = (j == x) ? c : mine; }
        if (sum == G) break;
        __builtin_amdgcn_s_sleep(1);
        if ((++sp & 255u) == 0u) { if (xb_ld(&bar[XB_TMO])) break; if (sp > XB_SPIN_CAP) { atomicAdd(&bar[XB_TMO], 1u); break; } }
    }
    nloc = mine > 0u ? mine : 1u; nx = cnt > 0u ? cnt : 1u;
}

__device__ __forceinline__ void xcd_barrier(const XcdBarrier& b) {
    asm volatile("s_waitcnt vmcnt(0)" ::: "memory");
    __syncthreads();
    if (threadIdx.x == 0) {
        unsigned* bar = b.bar;
        __builtin_amdgcn_s_waitcnt(0);
        unsigned nloc = b.st[0], nx = b.st[1];
        if (nloc == 0u) { xcd_barrier_complete(bar, b.x, nloc, nx); b.st[0] = nloc; b.st[1] = nx; }
        const unsigned old = xb_add(&bar[XB_XSUB(b.x)], 1u);
        const unsigned gen = old / nloc;
        if (old + 1u == (gen + 1u) * nloc) {
            __builtin_amdgcn_fence(__ATOMIC_RELEASE, "agent");
            asm volatile("s_waitcnt vmcnt(0)" ::: "memory");
            const unsigned og = xb_add(&bar[XB_TOP], 1u);
            const unsigned tg = og / nx;
            if (og + 1u == (tg + 1u) * nx) xb_add(&bar[XB_TOPGEN], 1u);
            else XB_SPIN(xb_ld(&bar[XB_TOPGEN]) == tg, bar);
            __builtin_amdgcn_fence(__ATOMIC_ACQUIRE, "agent");
            xb_add(&bar[XB_XGEN(b.x)], 1u);
            asm volatile("s_waitcnt vmcnt(0)" ::: "memory");
        } else {
            XB_SPIN(xb_ld(&bar[XB_XGEN(b.x)]) == gen, bar);
            __builtin_amdgcn_fence(__ATOMIC_ACQUIRE, "agent");
            asm volatile("s_waitcnt vmcnt(0)" ::: "memory");
        }
    }
    __syncthreads();
}

struct Args { const float* in[15]; float* out; unsigned char* ws; int ph_lo, ph_hi; };
__global__ void __launch_bounds__(512, 2) mk_fwd(Args a) {
    extern __shared__ __attribute__((aligned(16))) unsigned char lds_raw[];
    ldsp lds = (ldsp)lds_raw;
    cg::grid_group grid = cg::this_grid();
    const int G = gridDim.x, bx = blockIdx.x;
    volatile LAS unsigned* bst = (volatile LAS unsigned*)(lds + LDS_BYTES - 64);
    if (threadIdx.x < 2) bst[threadIdx.x] = 0u;
    __syncthreads();
    const XcdBarrier bar = xcd_barrier_post((unsigned*)a.ws + CW_BAR, bst);
    for (int ph = a.ph_lo; ph < a.ph_hi; ++ph) {
        int tid = threadIdx.x; asm volatile("" : "+v"(tid));
        unsigned char* ws = a.ws; asm volatile("" : "+s"(ws));
        float* out = a.out; asm volatile("" : "+s"(out));
        const int lane = tid & 63, wave = __builtin_amdgcn_readfirstlane(tid >> 6);
        const int gw = bx * 8 + wave, ngw = G * 8;
        bf16* XB = (bf16*)(ws + WS_XB); bf16* MIX = (bf16*)(ws + WS_MIX); bf16* X1 = (bf16*)out; float* Lbuf = out; float* DEC = (float*)(ws + WS_DEC);
        bf16* QB = (bf16*)(ws + WS_QB); float* LF = (float*)(ws + WS_LF); bf16* VB = (bf16*)(ws + WS_VB); bf16* GB = (bf16*)(ws + WS_GB); bf16* BB = (bf16*)(ws + WS_BB); bf16* UB = (bf16*)(ws + WS_UB);
        bf16* HID = (bf16*)(ws + WS_HID);
        if (ph == 0 && (PHMASK & 512)) {
            p0_phase(lds, a.in, ws, gw, ngw, wave, lane);
        } else {
            const int layer = (ph - 1) / 9, kind = (ph - 1) % 9;
            const unsigned char* wl = ws + WS_W + (size_t)layer * W_LAYER;
            if (kind == 0 && (PHMASK & 1)) {
                pg8::Gemm g{(const bf16*)XB, (const bf16*)(wl + W_IN), TT, PW, DM, DM}; pg8::StaticOrder S; S.init(TT, PW, G, bx);
                EpiProj E{QB, VB, GB, BB, UB, LF, a.in[5], layer};
                pg8::gemm_phase<EpiProj, pg8::StaticOrder, true, true>(lds, g, S, E);
            } else if (kind == 1 && (PHMASK & 2)) {
                for (int u = bx; u < NPU + NSU; u += G) {
                    __syncthreads();
                    if (u < NPU) h1_prompt_unit(lds, u, LF, VB, Lbuf, DEC, tid, wave, lane);
                    else h_sample_unit(lds, u - NPU, layer, LF, QB, VB, GB, a.in[2], a.in[7], MIX, out, tid, wave, lane);
                }
            } else if (kind == 2 && (PHMASK & 4)) {
                h2_phase(layer, Lbuf, DEC, out, UB, BB, a.in[3], a.in[6], MIX, bx * 512 + tid, G * 512);
            } else if (kind == 3 && (PHMASK & 8)) {
                for (int u = bx; u < NPU; u += G) { __syncthreads(); h3_prompt_unit(lds, u, layer, LF, QB, VB, GB, Lbuf, a.in[7], MIX, tid, wave, lane); }
            } else if ((kind == 4 || kind == 7) && (PHMASK & 16)) {
                const bool second = (kind == 7);
                const bf16* Aop = second ? (const bf16*)HID : (const bf16*)MIX; const bf16* Bop = (const bf16*)(wl + (second ? W_FF2 : W_OUT)); const int Kfull = second ? FF : DM;
                {
                    pg8::Gemm g{Aop, Bop, TP, DM, Kfull, Kfull}; pg8::StaticOrder S; S.init(TP, DM, G, bx);
                    EpiRes E{second ? (const bf16*)X1 : (const bf16*)XB, second ? XB : X1};
                    pg8::gemm_phase<EpiRes, pg8::StaticOrder, true, true>(lds, g, S, E);
                }
                {
                    const int nsplit = second ? NSPLIT4 : NSPLIT2;
                    pg8::Gemm g{Aop, Bop, TT, DM, Kfull / nsplit, Kfull}; pg8::SplitOrder S; S.init(TP / 256, TS / 256, DM, nsplit, G, bx);
                    EpiPart E{(float*)(ws + (second ? WS_PART4 : WS_PART2)), second ? (const bf16*)X1 : (const bf16*)XB};
                    pg8::gemm_phase<EpiPart, pg8::SplitOrder, true, true>(lds, g, S, E);
                }
            } else if (kind == 5 && (PHMASK & 32)) {
                ln_phase(X1, (const float*)(ws + WS_PART2), NSPLIT2, a.in[9] + layer * DM, a.in[10] + layer * DM, nullptr, gw, ngw, lane);
            } else if (kind == 6 && (PHMASK & 64)) {
                pg8::Gemm g{(const bf16*)X1, (const bf16*)(wl + W_FF1), TT, FF, DM, DM}; pg8::StaticOrder S; S.init(TT, FF, G, bx);
                EpiRelu2 E{HID};
                pg8::gemm_phase<EpiRelu2, pg8::StaticOrder, true, true>(lds, g, S, E);
            } else if (PHMASK & 256) {
                ln_phase(XB, (const float*)(ws + WS_PART4), NSPLIT4, a.in[13] + layer * DM, a.in[14] + layer * DM, (layer == 1) ? out + O_Y : nullptr, gw, ngw, lane);
            }
        }
        if (ph + 1 < a.ph_hi) { if (ph == a.ph_lo) grid.sync(); else xcd_barrier(bar); }
    }
}

extern "C" void kernel_launch(void* const* d_in, const int* in_sizes, int n_in, void* d_out, int out_size, void* d_ws, size_t ws_size, hipStream_t stream) {
    static int grid = 0;
    if (grid == 0) {
        if (n_in != 15 || in_sizes[0] != TP * DM || (size_t)out_size != O_END || ws_size < WS_END) {
            fprintf(stderr, "kernel_launch: unexpected shapes (n_in %d in0 %d out %d ws %zu); nothing launched\n", n_in, n_in > 0 ? in_sizes[0] : -1, out_size, ws_size); grid = -1; return; }
        int dev = 0, cus = 0, per_cu = 0;
        (void)hipGetDevice(&dev); (void)hipDeviceGetAttribute(&cus, hipDeviceAttributeMultiprocessorCount, dev);
        if (hipFuncSetAttribute((const void*)mk_fwd, hipFuncAttributeMaxDynamicSharedMemorySize, LDS_BYTES) != hipSuccess) { fprintf(stderr, "kernel_launch: hipFuncSetAttribute failed\n"); grid = -1; return; }
        if (hipOccupancyMaxActiveBlocksPerMultiprocessor(&per_cu, (const void*)mk_fwd, 512, LDS_BYTES) != hipSuccess || per_cu < 1) { fprintf(stderr, "kernel_launch: occupancy query says %d\n", per_cu); per_cu = 1; }
        (void)hipGetLastError();
        grid = cus > 0 ? cus : 256;
    }
    if (grid < 0) return;
    if (hipMemsetAsync(d_ws, 0, 65536, stream) != hipSuccess) { fprintf(stderr, "kernel_launch: memset failed\n"); return; }
    Args a{};
    for (int i = 0; i < 15; ++i) a.in[i] = (const float*)d_in[i];
    a.out = (float*)d_out; a.ws = (unsigned char*)d_ws;
    for (int lo = 0; lo < NPHASE; lo += (MK_N_LAUNCHES == 1 ? NPHASE : 1))
      for (int rep = 0; rep < ((MK_N_LAUNCHES != 1 && lo > 0 && ((REPMASK >> ((lo - 1) % 9)) & 1)) ? 2 : 1); ++rep) {
        a.ph_lo = lo; a.ph_hi = (MK_N_LAUNCHES == 1) ? NPHASE : lo + 1;
        void* args[] = {&a};
        const hipError_t e = hipLaunchCooperativeKernel((const void*)mk_fwd, dim3(grid), dim3(512), args, LDS_BYTES, stream);
        if (e != hipSuccess) { fprintf(stderr, "kernel_launch: cooperative launch failed: %s (grid %d)\n", hipGetErrorString(e), grid); break; }
    }
}
```

```cpp
#include <hip/hip_runtime.h>
#include <hip/hip_cooperative_groups.h>
#include <cstdio>
#include <cstdint>
namespace cg = cooperative_groups;
#define MK_N_LAUNCHES 1
#define REPMASK 0
namespace pg8 {
#define PG8_LAS __attribute__((address_space(3)))
typedef unsigned short bf16_t;
typedef short bf16x8 __attribute__((ext_vector_type(8)));
typedef float f32x4 __attribute__((ext_vector_type(4)));
typedef unsigned u32x4 __attribute__((ext_vector_type(4)));
constexpr int BM = 256, BK = 64, HALF = 128, HTB = HALF * BK * 2  , STAGE_BYTES = 8 * HTB, NXCD = 8, WGM = 8;

__host__ __device__ __forceinline__ int lds_byte(int r, int c) { const int st = (r >> 4) * 2 + (c >> 5), rr = r & 15, cc = c & 31, ob = rr * 64 + cc * 2; return st * 1024 + (ob ^ (((ob >> 9) & 1) << 5)); }
__host__ __device__ __forceinline__ void stage_rc(int b, int& R, int& C) { const int st = b / 1024, sb = b % 1024, swz = sb ^ (((sb >> 9) & 1) << 5); R = (st >> 1) * 16 + swz / 64; C = (st & 1) * 32 + (swz % 64) / 2; }
__host__ __device__ __forceinline__ int perm32(int rho) { const int n = rho >> 4, i = rho & 15; return 8 * (i >> 2) + 4 * n + (i & 3); }

struct Unit { int pm, pn, ks; };
struct Gemm { const bf16_t* A; const bf16_t* Bt; int M, N, K, ld; };

struct StaticOrder {
    int nM, nN, nwg, G, c;
    __host__ __device__ void init(int M, int N, int G_, int c_) { nM = M / BM; nN = N / BM; nwg = nM * nN; G = G_; c = c_; }
    __host__ __device__ bool next(int i, Unit& u) const {
        const long L = (long)i * G + c; if (L >= nwg) return false;
        int wgid = (int)L; { const int q = nwg / NXCD, r = nwg % NXCD, xcd = wgid % NXCD, off = wgid / NXCD; wgid = (xcd < r ? xcd * (q + 1) : r * (q + 1) + (xcd - r) * q) + off; }
        const int nig = WGM * nN, gid = wgid / nig, fm = gid * WGM, gsz = (nM - fm) < WGM ? (nM - fm) : WGM;
        u.pm = fm + ((wgid % nig) % gsz); u.pn = (wgid % nig) / gsz; u.ks = 0; return true;
    }
    __device__ __forceinline__ void a_ready(const Unit&) const {}
    __device__ __forceinline__ void done(const Unit&) const {}
};
struct SplitOrder {
    int pm0, nN, nsplit, total, G, c;
    __host__ __device__ void init(int pm0_, int npm, int N, int nsplit_, int G_, int c_) { pm0 = pm0_; nN = N / BM; nsplit = nsplit_; total = npm * nN * nsplit_; G = G_; c = c_; }
    __host__ __device__ bool next(int i, Unit& u) const {
        const int L = i * G + c; if (L >= total) return false;
        u.ks = L % nsplit; const int tile = L / nsplit; u.pn = tile % nN; u.pm = pm0 + tile / nN; return true;
    }
    __device__ __forceinline__ void a_ready(const Unit&) const {}
    __device__ __forceinline__ void done(const Unit&) const {}
};


__device__ __forceinline__ unsigned cvt_pk_bf16(float lo, float hi) { unsigned r; asm volatile("v_cvt_pk_bf16_f32 %0, %1, %2" : "=v"(r) : "v"(lo), "v"(hi)); return r; }
template <class Epi, class Sched, bool ALIGN_EPI = false, bool SP2 = false>
__device__ __forceinline__ void gemm_phase(PG8_LAS unsigned char* lds, const Gemm g, const Sched& S, const Epi& E) {
    int tid_ = threadIdx.x; asm volatile("" : "+v"(tid_));
    const int tid = tid_, wid = __builtin_amdgcn_readfirstlane(tid >> 6), lane = tid & 63, wr = wid >> 2, wc = wid & 3, fr = lane & 15, fq = lane >> 4;
    const int K = g.ld, nt = g.K / BK;
    unsigned voffA[2], voffB[2];
#pragma unroll
    for (int i = 0; i < 2; ++i) { int R, C; stage_rc(tid * 16 + i * 8192, R, C); const int Rb = Epi::PERM ? ((R & ~31) + perm32(R & 31)) : R;
        voffA[i] = (unsigned)(R * K + C) * 2u; voffB[i] = (unsigned)(Rb * K + C) * 2u; }
    const size_t kstep = (size_t)(BK * 2);
    const size_t hstep = (size_t)HALF * K * 2;
    const size_t tstep = 2 * hstep;
    const unsigned ldsw = (unsigned)wid * 1024u;
    const int aoff = lds_byte(wr * 64 + fr, fq * 8), boff = lds_byte(wc * 32 + fr, fq * 8);
#define PG8_SA(b, h) (((b) * 2 + (h)) * HTB)
#define PG8_SB(b, h) ((4 + (b) * 2 + (h)) * HTB)
#define PG8_STAGE(bufoff, gbase, voff) do { _Pragma("unroll") for (int _i = 0; _i < 2; ++_i) \
        __builtin_amdgcn_global_load_lds((const unsigned*)((const char*)(gbase) + (voff)[_i]), (PG8_LAS unsigned*)(lds + (bufoff) + ldsw + _i * 8192), 16, 0, 0); } while (0)
#define PG8_LDA(dst, b, h) do { _Pragma("unroll") for (int m = 0; m < 4; ++m) _Pragma("unroll") for (int k = 0; k < 2; ++k) dst[m][k] = *(const PG8_LAS bf16x8*)(lds + PG8_SA(b, h) + aoff + m * 2048 + k * 1024); } while (0)
#define PG8_LDB(dst, b, h) do { _Pragma("unroll") for (int n = 0; n < 2; ++n) _Pragma("unroll") for (int k = 0; k < 2; ++k) dst[n][k] = *(const PG8_LAS bf16x8*)(lds + PG8_SB(b, h) + boff + n * 2048 + k * 1024); } while (0)
#define PG8_MMA(ai, bj, At, Bt) do { __builtin_amdgcn_s_setprio(1); _Pragma("unroll") for (int m = 0; m < 4; ++m) _Pragma("unroll") for (int n = 0; n < 2; ++n) _Pragma("unroll") for (int k = 0; k < 2; ++k) \
        acc[ai][bj][m][n] = __builtin_amdgcn_mfma_f32_16x16x32_bf16(Bt[n][k], At[m][k], acc[ai][bj][m][n], 0, 0, 0); __builtin_amdgcn_s_setprio(0); } while (0)
#define PG8_WAIT_V(n) asm volatile("s_waitcnt vmcnt(" #n ")" ::: "memory")
#define PG8_WAIT_L(n) asm volatile("s_waitcnt lgkmcnt(" #n ")" ::: "memory")
#define PG8_BAR __builtin_amdgcn_s_barrier()
#define PG8_SCHED __builtin_amdgcn_sched_barrier(0)
    Unit cur, nxt; int ui = 0;
    if (!S.next(0, cur)) return;
    f32x4 acc[2][2][4][2];
#pragma unroll
    for (int a = 0; a < 2; ++a)
#pragma unroll
        for (int b = 0; b < 2; ++b)
#pragma unroll
            for (int m = 0; m < 4; ++m)
#pragma unroll
                for (int n = 0; n < 2; ++n) acc[a][b][m][n] = (f32x4){0.f, 0.f, 0.f, 0.f};
    bf16x8 At[4][2], B0[2][2], B1[2][2];
    const size_t kslice = (size_t)g.K * 2;
    const char* cA = (const char*)g.A + (size_t)cur.pm * tstep + (size_t)cur.ks * kslice; const char* cB = (const char*)g.Bt + (size_t)cur.pn * tstep + (size_t)cur.ks * kslice;
    S.a_ready(cur);
    if constexpr (SP2) {
        PG8_STAGE(PG8_SB(0, 0), cB, voffB); PG8_STAGE(PG8_SB(0, 1), cB + hstep, voffB); PG8_STAGE(PG8_SA(0, 0), cA, voffA); PG8_STAGE(PG8_SA(0, 1), cA + hstep, voffA);
        if (wr == 1) PG8_BAR;
        PG8_WAIT_V(2); PG8_BAR;
        PG8_STAGE(PG8_SB(1, 0), cB + kstep, voffB); PG8_STAGE(PG8_SA(1, 0), cA + kstep, voffA); PG8_STAGE(PG8_SB(1, 1), cB + hstep + kstep, voffB);
        PG8_WAIT_V(6); PG8_BAR;
    } else {
        PG8_STAGE(PG8_SB(0, 0), cB, voffB); PG8_STAGE(PG8_SA(0, 0), cA, voffA); PG8_STAGE(PG8_SB(0, 1), cB + hstep, voffB); PG8_STAGE(PG8_SA(0, 1), cA + hstep, voffA);
        if (wr == 1) PG8_BAR;
        PG8_WAIT_V(4); PG8_BAR;
        PG8_STAGE(PG8_SB(1, 0), cB + kstep, voffB); PG8_STAGE(PG8_SA(1, 0), cA + kstep, voffA); PG8_STAGE(PG8_SB(1, 1), cB + hstep + kstep, voffB);
        PG8_WAIT_V(6); PG8_BAR;
    }
    for (;;) {
        const bool has_next = S.next(ui + 1, nxt);
        const char* nA = has_next ? (const char*)g.A + (size_t)nxt.pm * tstep + (size_t)nxt.ks * kslice : cA; const char* nB = has_next ? (const char*)g.Bt + (size_t)nxt.pn * tstep + (size_t)nxt.ks * kslice : cB;
        for (int t = 0; t < nt; t += 2) {
            const bool last = (t == nt - 2);
            const char* a1 = cA + (size_t)(t + 1) * kstep;
            const char* a2 = last ? nA : cA + (size_t)(t + 2) * kstep; const char* b2 = last ? nB : cB + (size_t)(t + 2) * kstep;
            const char* a3 = a2 + kstep; const char* b3 = b2 + kstep;
            if (last && has_next) S.a_ready(nxt);
            if constexpr (SP2) {
            PG8_LDB(B0, 0, 0); PG8_LDB(B1, 0, 1); PG8_SCHED; PG8_LDA(At, 0, 0); PG8_STAGE(PG8_SA(1, 1), a1 + hstep, voffA);
            PG8_WAIT_V(8); PG8_WAIT_L(0); PG8_BAR; PG8_MMA(0, 0, At, B0); PG8_MMA(0, 1, At, B1); PG8_BAR; PG8_SCHED;
            PG8_LDA(At, 0, 1); PG8_STAGE(PG8_SB(0, 0), b2, voffB); PG8_STAGE(PG8_SB(0, 1), b2 + hstep, voffB); PG8_STAGE(PG8_SA(0, 0), a2, voffA);
            PG8_WAIT_V(8); PG8_WAIT_L(0); PG8_BAR; PG8_MMA(1, 0, At, B0); PG8_MMA(1, 1, At, B1); PG8_BAR; PG8_SCHED;
            PG8_LDB(B0, 1, 0); PG8_LDB(B1, 1, 1); PG8_SCHED; PG8_LDA(At, 1, 0); PG8_STAGE(PG8_SA(0, 1), a2 + hstep, voffA);
            PG8_WAIT_V(8); PG8_WAIT_L(0); PG8_BAR; PG8_MMA(0, 0, At, B0); PG8_MMA(0, 1, At, B1); PG8_BAR; PG8_SCHED;
            PG8_LDA(At, 1, 1); PG8_STAGE(PG8_SB(1, 0), b3, voffB); PG8_STAGE(PG8_SB(1, 1), b3 + hstep, voffB); PG8_STAGE(PG8_SA(1, 0), a3, voffA);
            PG8_WAIT_V(8); PG8_WAIT_L(0); PG8_BAR; PG8_MMA(1, 0, At, B0); PG8_MMA(1, 1, At, B1); PG8_BAR; PG8_SCHED;
            } else {
            PG8_LDB(B0, 0, 0); PG8_SCHED; PG8_LDA(At, 0, 0); PG8_STAGE(PG8_SA(1, 1), a1 + hstep, voffA);
            PG8_WAIT_L(8); PG8_BAR; PG8_WAIT_L(0); PG8_MMA(0, 0, At, B0); PG8_BAR; PG8_SCHED;
            PG8_LDB(B1, 0, 1); PG8_STAGE(PG8_SB(0, 0), b2, voffB);
            PG8_BAR; PG8_WAIT_L(0); PG8_MMA(0, 1, At, B1); PG8_BAR;
            PG8_LDA(At, 0, 1); PG8_STAGE(PG8_SA(0, 0), a2, voffA);
            PG8_BAR; PG8_WAIT_L(0); PG8_MMA(1, 0, At, B0); PG8_BAR; PG8_SCHED;
            PG8_STAGE(PG8_SB(0, 1), b2 + hstep, voffB);
            PG8_WAIT_V(6); PG8_BAR; PG8_MMA(1, 1, At, B1); PG8_BAR;
            PG8_LDB(B0, 1, 0); PG8_SCHED; PG8_LDA(At, 1, 0); PG8_STAGE(PG8_SA(0, 1), a2 + hstep, voffA);
            PG8_WAIT_L(8); PG8_BAR; PG8_WAIT_L(0); PG8_MMA(0, 0, At, B0); PG8_BAR; PG8_SCHED;
            PG8_LDB(B1, 1, 1); PG8_STAGE(PG8_SB(1, 0), b3, voffB);
            PG8_BAR; PG8_WAIT_L(0); PG8_MMA(0, 1, At, B1); PG8_BAR;
            PG8_LDA(At, 1, 1); PG8_STAGE(PG8_SA(1, 0), a3, voffA);
            PG8_BAR; PG8_WAIT_L(0); PG8_MMA(1, 0, At, B0); PG8_BAR; PG8_SCHED;
            PG8_STAGE(PG8_SB(1, 1), b3 + hstep, voffB);
            PG8_WAIT_V(6); PG8_BAR; PG8_MMA(1, 1, At, B1); PG8_BAR;
            }
        }
        if constexpr (ALIGN_EPI) { if (wr == 0) PG8_BAR; }
        if constexpr (!Epi::AFTER_DRAIN) { E(acc, cur, wr, wc, fr, fq); S.done(cur); }
        if (!has_next) break;
#pragma unroll
        for (int a = 0; a < 2; ++a)
#pragma unroll
            for (int b = 0; b < 2; ++b)
#pragma unroll
                for (int m = 0; m < 4; ++m)
#pragma unroll
                    for (int n = 0; n < 2; ++n) acc[a][b][m][n] = (f32x4){0.f, 0.f, 0.f, 0.f};
        cur = nxt; cA = nA; cB = nB; ++ui;
        if constexpr (ALIGN_EPI) { if (wr == 1) PG8_BAR; }
    }
    PG8_WAIT_V(0);
    if constexpr (!ALIGN_EPI) { if (wr == 0) PG8_BAR; }
    PG8_BAR;
    if constexpr (Epi::AFTER_DRAIN) { E.fused(acc, cur, wr, wc, fr, fq, lds, wid, lane); S.done(cur); }
#undef PG8_SA
#undef PG8_SB
#undef PG8_STAGE
#undef PG8_LDA
#undef PG8_LDB
#undef PG8_MMA
#undef PG8_WAIT_V
#undef PG8_WAIT_L
#undef PG8_BAR
#undef PG8_SCHED
}
}

#ifndef REPMASK
#define REPMASK 0
#endif
#ifndef EXTRA_SYNC
#define EXTRA_SYNC 0
#endif
#ifndef PHMASK
#define PHMASK 1023
#endif
#ifndef MK_N_LAUNCHES
#define MK_N_LAUNCHES 1
#endif
#define LAS __attribute__((address_space(3)))
typedef unsigned short bf16;
typedef unsigned u32x4 __attribute__((ext_vector_type(4)));
typedef unsigned u32x2 __attribute__((ext_vector_type(2)));
typedef float f32x4 __attribute__((ext_vector_type(4)));
typedef short bf16x8 __attribute__((ext_vector_type(8)));
typedef LAS unsigned char* ldsp;

constexpr int TP = 16384, TS = 1024, TT = TP + TS, DM = 1024, FF = 4096, PW = 3584, HW = 512;
constexpr int SEQ = 2048, NCHUNK = 32, NPU = 1024  , NSU = 512  ;
constexpr float ALPHA = 1.4142135623730951f, LN_EPS = 1e-5f, RMS_EPS = 1e-6f;
constexpr size_t MiB = 1u << 20;
constexpr size_t WS_DEC = 1 * MiB, WS_W = 2 * MiB, W_LAYER = 25 * MiB, W_IN = 0, W_OUT = 7 * MiB, W_FF1 = 9 * MiB, W_FF2 = 17 * MiB;
constexpr size_t WS_XB = 52 * MiB, WS_MIX = 86 * MiB, WS_BIG = 120 * MiB;
constexpr size_t WS_QB = WS_BIG, WS_LF = WS_BIG + 17 * MiB, WS_VB = WS_BIG + 51 * MiB, WS_GB = WS_BIG + 68 * MiB, WS_BB = WS_BIG + 85 * MiB, WS_UB = WS_BIG + 102 * MiB;
constexpr size_t WS_HID = WS_BIG, WS_END = 256 * MiB;
constexpr size_t O_Y = 0, O_HP = (size_t)TT * DM, O_CP = O_HP + 2 * 8 * 4 * 16384, O_HS = O_CP + 2 * 8 * 2 * 512, O_CS = O_HS + (size_t)2 * 128 * 4 * 16384, O_END = O_CS + 2 * 128 * 2 * 512;
constexpr int LDS_BYTES = 147456;
constexpr int NPHASE = 19;
constexpr int NSPLIT2 = 4, NSPLIT4 = 8;
constexpr size_t WS_PART2 = WS_BIG  , WS_PART4 = WS_MIX  ;
constexpr int CW_BAR = 4096;

__device__ __forceinline__ float bflo(unsigned w) { return __uint_as_float(w << 16); }
__device__ __forceinline__ float bfhi(unsigned w) { return __uint_as_float(w & 0xffff0000u); }
__device__ __forceinline__ float bf1(bf16 h) { return __uint_as_float(((unsigned)h) << 16); }
__device__ __forceinline__ unsigned pk(float lo, float hi) { return pg8::cvt_pk_bf16(lo, hi); }
__device__ __forceinline__ bf16 tobf(float x) { return (bf16)(pg8::cvt_pk_bf16(x, 0.f) & 0xffffu); }
__device__ __forceinline__ float silu_f(float x) { return x / (1.f + __expf(-x)); }
__device__ __forceinline__ float wave_sum(float v) {
#pragma unroll
    for (int o = 1; o < 64; o <<= 1) v += __shfl_xor(v, o);
    return v;
}
#define MFMA16(a, b, c) __builtin_amdgcn_mfma_f32_16x16x32_bf16((a), (b), (c), 0, 0, 0)

struct EpiProj {
    static constexpr bool PERM = true, AFTER_DRAIN = false;
    bf16 *QB, *VB, *GB, *BB, *UB; float* LF; const float* lbl; int layer;
    __device__ __forceinline__ void operator()(const f32x4 (&acc)[2][2][4][2], const pg8::Unit& u, int wr, int wc, int fr, int fq) const {
        const int row0 = u.pm * 256 + wr * 64 + fr, cw = wc * 32 + 8 * fq;
        if (u.pn >= 10) {
            const int col = (u.pn - 10) * 128 + cw;
#pragma unroll
            for (int ai = 0; ai < 2; ++ai)
#pragma unroll
                for (int m = 0; m < 4; ++m) {
                    const f32x4 v0 = acc[ai][0][m][0] * acc[ai][1][m][0], v1 = acc[ai][0][m][1] * acc[ai][1][m][1];
                    u32x4 w; w.x = pk(v0[0], v0[1]); w.y = pk(v0[2], v0[3]); w.z = pk(v1[0], v1[1]); w.w = pk(v1[2], v1[3]);
                    *(u32x4*)(UB + (size_t)(row0 + ai * 128 + m * 16) * HW + col) = w;
                }
        } else {
            const int blk = u.pn >> 1, cb = (u.pn & 1) * 256 + cw;
            if (blk == 1) {
                f32x4 lb[2][2];
#pragma unroll
                for (int bj = 0; bj < 2; ++bj)
#pragma unroll
                    for (int n = 0; n < 2; ++n)
#pragma unroll
                        for (int e = 0; e < 4; ++e) { const int col = cb + bj * 128 + 4 * n + e; lb[bj][n][e] = (layer == 0) ? 0.f : 1.f / (1.f + __expf(lbl[col] - lbl[HW + col])); }
#pragma unroll
                for (int ai = 0; ai < 2; ++ai)
#pragma unroll
                    for (int m = 0; m < 4; ++m)
#pragma unroll
                        for (int bj = 0; bj < 2; ++bj) {
                            float* dst = LF + (size_t)(row0 + ai * 128 + m * 16) * HW + cb + bj * 128;
#pragma unroll
                            for (int n = 0; n < 2; ++n) {
                                f32x4 o;
#pragma unroll
                                for (int e = 0; e < 4; ++e) {
                                    const float z = acc[ai][bj][m][n][e], l = lb[bj][n][e];
                                    const float ls = fminf(z, 0.f) - __logf(1.f + __expf(-fabsf(z)));
                                    o[e] = (l > 0.f) ? __logf(l + (1.f - l) * __expf(ls)) : ls;
                                }
                                *(f32x4*)(dst + 4 * n) = o;
                            }
                        }
            } else {
                bf16* dst0 = (blk == 0) ? QB : (blk == 2) ? VB : (blk == 3) ? GB : BB;
                const bool act = (blk == 0) || (blk == 3);
#pragma unroll
                for (int ai = 0; ai < 2; ++ai)
#pragma unroll
                    for (int m = 0; m < 4; ++m)
#pragma unroll
                        for (int bj = 0; bj < 2; ++bj) {
                            f32x4 v0 = acc[ai][bj][m][0], v1 = acc[ai][bj][m][1];
                            if (act) {
#pragma unroll
                                for (int e = 0; e < 4; ++e) { v0[e] = silu_f(v0[e]); v1[e] = silu_f(v1[e]); }
                            }
                            u32x4 w; w.x = pk(v0[0], v0[1]); w.y = pk(v0[2], v0[3]); w.z = pk(v1[0], v1[1]); w.w = pk(v1[2], v1[3]);
                            *(u32x4*)(dst0 + (size_t)(row0 + ai * 128 + m * 16) * HW + cb + bj * 128) = w;
                        }
            }
        }
    }
};
struct EpiRes {
    static constexpr bool PERM = true, AFTER_DRAIN = false;
    const bf16* res; bf16* out;
    __device__ __forceinline__ void operator()(const f32x4 (&acc)[2][2][4][2], const pg8::Unit& u, int wr, int wc, int fr, int fq) const {
        const int row0 = u.pm * 256 + wr * 64 + fr, c0 = u.pn * 256 + wc * 32 + 8 * fq;
#pragma unroll
        for (int ai = 0; ai < 2; ++ai)
#pragma unroll
            for (int m = 0; m < 4; ++m)
#pragma unroll
                for (int bj = 0; bj < 2; ++bj) {
                    const size_t off = (size_t)(row0 + ai * 128 + m * 16) * DM + c0 + bj * 128;
                    const u32x4 r = *(const u32x4*)(res + off);
                    const f32x4 a0 = acc[ai][bj][m][0], a1 = acc[ai][bj][m][1];
                    u32x4 w;
                    w.x = pk(a0[0] + ALPHA * bflo(r.x), a0[1] + ALPHA * bfhi(r.x)); w.y = pk(a0[2] + ALPHA * bflo(r.y), a0[3] + ALPHA * bfhi(r.y));
                    w.z = pk(a1[0] + ALPHA * bflo(r.z), a1[1] + ALPHA * bfhi(r.z)); w.w = pk(a1[2] + ALPHA * bflo(r.w), a1[3] + ALPHA * bfhi(r.w));
                    *(u32x4*)(out + off) = w;
                }
    }
};
struct EpiRelu2 {
    static constexpr bool PERM = true, AFTER_DRAIN = false;
    bf16* out;
    __device__ __forceinline__ void operator()(const f32x4 (&acc)[2][2][4][2], const pg8::Unit& u, int wr, int wc, int fr, int fq) const {
        const int row0 = u.pm * 256 + wr * 64 + fr, c0 = u.pn * 256 + wc * 32 + 8 * fq;
#pragma unroll
        for (int ai = 0; ai < 2; ++ai)
#pragma unroll
            for (int m = 0; m < 4; ++m)
#pragma unroll
                for (int bj = 0; bj < 2; ++bj) {
                    f32x4 a0 = acc[ai][bj][m][0], a1 = acc[ai][bj][m][1];
#pragma unroll
                    for (int e = 0; e < 4; ++e) { const float x = fmaxf(a0[e], 0.f), y = fmaxf(a1[e], 0.f); a0[e] = x * x; a1[e] = y * y; }
                    u32x4 w; w.x = pk(a0[0], a0[1]); w.y = pk(a0[2], a0[3]); w.z = pk(a1[0], a1[1]); w.w = pk(a1[2], a1[3]);
                    *(u32x4*)(out + (size_t)(row0 + ai * 128 + m * 16) * FF + c0 + bj * 128) = w;
                }
    }
};

struct EpiPart {
    static constexpr bool PERM = true, AFTER_DRAIN = false;
    float* part; const bf16* res;
    __device__ __forceinline__ void operator()(const f32x4 (&acc)[2][2][4][2], const pg8::Unit& u, int wr, int wc, int fr, int fq) const {
        const int row0 = u.pm * 256 + wr * 64 + fr - TP, c0 = u.pn * 256 + wc * 32 + 8 * fq;
        float* base = part + (size_t)u.ks * TS * DM;
#pragma unroll
        for (int ai = 0; ai < 2; ++ai)
#pragma unroll
            for (int m = 0; m < 4; ++m)
#pragma unroll
                for (int bj = 0; bj < 2; ++bj) {
                    float* d = base + (size_t)(row0 + ai * 128 + m * 16) * DM + c0 + bj * 128;
                    f32x4 a0 = acc[ai][bj][m][0], a1 = acc[ai][bj][m][1];
                    if (u.ks == 0) { const u32x4 r = *(const u32x4*)(res + (size_t)(row0 + TP + ai * 128 + m * 16) * DM + c0 + bj * 128);
                        a0[0] += ALPHA * bflo(r.x); a0[1] += ALPHA * bfhi(r.x); a0[2] += ALPHA * bflo(r.y); a0[3] += ALPHA * bfhi(r.y);
                        a1[0] += ALPHA * bflo(r.z); a1[1] += ALPHA * bfhi(r.z); a1[2] += ALPHA * bflo(r.w); a1[3] += ALPHA * bfhi(r.w); }
                    *(f32x4*)d = a0; *(f32x4*)(d + 4) = a1;
                }
    }
};

__device__ __forceinline__ int remap_in(int n0) {
    if (n0 < 2560) return n0;
    if (n0 < 3072) { const int c = n0 - 2560; return 2560 + 256 * (c >> 7) + (c & 127); }
    const int c = n0 - 3072; return 2560 + 256 * (c >> 7) + 128 + (c & 127);
}
__device__ __forceinline__ void transpose_item(const float* W, int K, int N, bf16* WT, bool remap, LAS float* scr, int item, int lane) {
    const int nblk = N / 32, kb = item / nblk, nb = item % nblk, k0 = 64 * kb, n0 = 32 * nb;
    const int d0 = remap ? remap_in(n0) : n0;
#pragma unroll 8
    for (int i = 0; i < 32; ++i) { const int kk = 2 * i + (lane >> 5); scr[kk * 33 + (lane & 31)] = W[(size_t)(k0 + kk) * N + n0 + (lane & 31)]; }
    asm volatile("s_waitcnt lgkmcnt(0)" ::: "memory");
    const int c = lane & 7;
#pragma unroll
    for (int j = 0; j < 4; ++j) { const int n = (lane >> 3) + 8 * j; const LAS float* s = scr + (8 * c) * 33 + n;
        u32x4 o; o.x = pk(s[0 * 33], s[1 * 33]); o.y = pk(s[2 * 33], s[3 * 33]); o.z = pk(s[4 * 33], s[5 * 33]); o.w = pk(s[6 * 33], s[7 * 33]);
        *(u32x4*)(WT + (size_t)(d0 + n) * K + k0 + 8 * c) = o; }
    asm volatile("s_waitcnt lgkmcnt(0)" ::: "memory");
}
__device__ __forceinline__ void p0_phase(ldsp lds, const float* const* in, unsigned char* ws, int gw, int ngw, int wave, int lane) {
    LAS float* scr = (LAS float*)(lds + wave * 16384);
    constexpr int I_IN = 16 * 112, I_OUT = 16 * 32, I_F1 = 16 * 128, I_F2 = 64 * 32, I_L = I_IN + I_OUT + I_F1 + I_F2;
    for (int it = gw; it < 2 * I_L; it += ngw) {
        const int l = it / I_L; int r = it % I_L;
        unsigned char* wl = ws + WS_W + (size_t)l * W_LAYER;
        if (r < I_IN) { transpose_item(in[4] + (size_t)l * DM * PW, DM, PW, (bf16*)(wl + W_IN), true, scr, r, lane); continue; } r -= I_IN;
        if (r < I_OUT) { transpose_item(in[8] + (size_t)l * DM * DM, DM, DM, (bf16*)(wl + W_OUT), false, scr, r, lane); continue; } r -= I_OUT;
        if (r < I_F1) { transpose_item(in[11] + (size_t)l * DM * FF, DM, FF, (bf16*)(wl + W_FF1), false, scr, r, lane); continue; } r -= I_F1;
        transpose_item(in[12] + (size_t)l * FF * DM, FF, DM, (bf16*)(wl + W_FF2), false, scr, r, lane);
    }
    bf16* XB = (bf16*)(ws + WS_XB);
    for (int r = gw; r < TT; r += ngw) {
        const float* src = (r < TP) ? in[0] + (size_t)r * DM : in[1] + (size_t)(r - TP) * DM;
#pragma unroll
        for (int j = 0; j < 4; ++j) { const f32x4 v = *(const f32x4*)(src + 4 * lane + 256 * j); u32x2 w; w.x = pk(v[0], v[1]); w.y = pk(v[2], v[3]); *(u32x2*)(XB + (size_t)r * DM + 4 * lane + 256 * j) = w; }
    }
}

constexpr int L_BS = 0, L_QS = 32768, L_KS = 50176, L_KT = 32768, L_VT = 67584, L_ST = 86016, L_PP = 120832, L_SEG = 130048, L_RED = 132096;
constexpr int RS128 = 272, RS64 = 144;

struct HPre { f32x4 lf[4]; unsigned v[8]; };
struct H3Pre { HPre b; u32x4 q[2]; float s[32]; u32x2 g[4]; };
__device__ __forceinline__ void hpre_issue(HPre& P, int unit, const float* LF, const bf16* VB, int tid) {
    const int bh = unit >> 5, n = unit & 31, b = bh >> 2, h = bh & 3, tok0 = b * SEQ + n * 64;
#pragma unroll
    for (int j = 0; j < 4; ++j) { const int idx = tid + 512 * j, t = idx >> 5, c4 = idx & 31; P.lf[j] = *(const f32x4*)(LF + (size_t)(tok0 + t) * HW + h * 128 + 4 * c4); }
    const int c2 = tid & 63, sgp = tid >> 6;
#pragma unroll
    for (int e = 0; e < 8; ++e) P.v[e] = *(const unsigned*)(VB + (size_t)(tok0 + 8 * sgp + e) * HW + h * 128 + 2 * c2);
}
__device__ __forceinline__ void h3pre_issue(H3Pre& P, int unit, const float* LF, const bf16* QB, const bf16* VB, const bf16* GB, const float* Sbuf, int tid, int wave, int lane) {
    hpre_issue(P.b, unit, LF, VB, tid);
    const int bh = unit >> 5, n = unit & 31, b = bh >> 2, h = bh & 3, tok0 = b * SEQ + n * 64;
#pragma unroll
    for (int j = 0; j < 2; ++j) { const int idx = tid + 512 * j, t = idx >> 4, c8 = idx & 15; P.q[j] = *(const u32x4*)(QB + (size_t)(tok0 + t) * HW + h * 128 + 8 * c8); }
    const float* Su = Sbuf + (size_t)unit * 16384 + (tid & 127) + (size_t)(32 * (tid >> 7)) * 128;
#pragma unroll
    for (int i = 0; i < 32; ++i) P.s[i] = Su[i * 128];
    const int fr = lane & 15, fq = lane >> 4, tm = wave >> 1, vh = wave & 1;
    const size_t row = (size_t)(tok0 + 16 * tm + fr);
#pragma unroll
    for (int i = 0; i < 4; ++i) P.g[i] = *(const u32x2*)(GB + row * HW + h * 128 + 16 * (4 * vh + i) + 4 * fq);
}
__device__ __forceinline__ void stage_cumsum(ldsp lds, const HPre& P, float (&kk)[16], int tid) {
    LAS float* BS = (LAS float*)(lds + L_BS); LAS float* SEG = (LAS float*)(lds + L_SEG);
#pragma unroll
    for (int j = 0; j < 4; ++j) { const int idx = tid + 512 * j, t = idx >> 5, c4 = idx & 31; *(LAS f32x4*)(BS + t * 128 + 4 * c4) = P.lf[j]; }
    {
        const int c2 = tid & 63, sgp = tid >> 6; const unsigned* w = P.v;
        u32x4 lo, hi;
        lo.x = (w[0] & 0xffffu) | (w[1] << 16); lo.y = (w[2] & 0xffffu) | (w[3] << 16); lo.z = (w[4] & 0xffffu) | (w[5] << 16); lo.w = (w[6] & 0xffffu) | (w[7] << 16);
        hi.x = (w[0] >> 16) | (w[1] & 0xffff0000u); hi.y = (w[2] >> 16) | (w[3] & 0xffff0000u); hi.z = (w[4] >> 16) | (w[5] & 0xffff0000u); hi.w = (w[6] >> 16) | (w[7] & 0xffff0000u);
        *(LAS u32x4*)(lds + L_VT + (2 * c2) * RS64 + 16 * sgp) = lo;
        *(LAS u32x4*)(lds + L_VT + (2 * c2 + 1) * RS64 + 16 * sgp) = hi;
    }
    __syncthreads();
    const int c = tid & 127, sg = tid >> 7;
    float run = 0.f;
#pragma unroll
    for (int i = 0; i < 16; ++i) { const int t = sg * 16 + i; const float lf = BS[t * 128 + c]; kk[i] = 1.f - __expf(lf); run += lf; BS[t * 128 + c] = run; }
    SEG[sg * 128 + c] = run;
    __syncthreads();
    float off = 0.f;
    for (int s = 0; s < sg; ++s) off += SEG[s * 128 + c];
#pragma unroll
    for (int i = 0; i < 16; ++i) BS[(sg * 16 + i) * 128 + c] += off;
    __syncthreads();
}

__device__ __forceinline__ void h1_prompt_units(ldsp lds, int u0, int G, const float* LF, const bf16* VB, float* Lbuf, float* DEC, int tid, int wave, int lane) {
    if (u0 >= NPU) return;
    HPre P; hpre_issue(P, u0, LF, VB, tid);
    for (int unit = u0; unit < NPU; unit += G) {
        __syncthreads();
        float kk[16];
        stage_cumsum(lds, P, kk, tid);
        if (unit + G < NPU) hpre_issue(P, unit + G, LF, VB, tid);
        LAS float* BS = (LAS float*)(lds + L_BS);
        const int c = tid & 127, sg = tid >> 7;
        const float blast = BS[63 * 128 + c];
#pragma unroll
        for (int hf = 0; hf < 2; ++hf) {
            float kd[8];
#pragma unroll
            for (int e = 0; e < 8; ++e) { const int i = hf * 8 + e; kd[e] = kk[i] * __expf(blast - BS[(sg * 16 + i) * 128 + c]); }
            u32x4 w; w.x = pk(kd[0], kd[1]); w.y = pk(kd[2], kd[3]); w.z = pk(kd[4], kd[5]); w.w = pk(kd[6], kd[7]);
            *(LAS u32x4*)(lds + L_KT + c * RS64 + (sg * 16 + hf * 8) * 2) = w;
        }
        if (sg == 0) DEC[unit * 128 + c] = __expf(blast);
        __syncthreads();
        const int fr = lane & 15, fq = lane >> 4;
        bf16x8 bk[2];
#pragma unroll
        for (int k2 = 0; k2 < 2; ++k2) bk[k2] = *(const LAS bf16x8*)(lds + L_KT + (16 * wave + fr) * RS64 + (32 * k2 + 8 * fq) * 2);
        float* Lu = Lbuf + (size_t)unit * 16384;
#pragma unroll
        for (int mt = 0; mt < 8; ++mt) {
            f32x4 acc = {0.f, 0.f, 0.f, 0.f};
#pragma unroll
            for (int k2 = 0; k2 < 2; ++k2) { const bf16x8 a = *(const LAS bf16x8*)(lds + L_VT + (16 * mt + fr) * RS64 + (32 * k2 + 8 * fq) * 2); acc = MFMA16(a, bk[k2], acc); }
            *(f32x4*)(Lu + (16 * wave + fr) * 128 + 16 * mt + 4 * fq) = acc;
        }
    }
}

__device__ __forceinline__ void h_sample_unit(ldsp lds, int su, int layer, const float* LF, const bf16* QB, const bf16* VB, const bf16* GB, const float* state_hgrn, const float* onorm,
                                              bf16* MIX, float* out, int tid, int wave, int lane) {
    const int b = su >> 2, h = su & 3, R0 = TP + b * 8;
    const size_t so = (((size_t)layer * 128 + b) * 4 + h) * 16384;
    f32x4 s0r[8];
    { const float* S0p = state_hgrn + so + (size_t)(8 * (tid >> 5)) * 128 + 4 * (tid & 31);
#pragma unroll
      for (int i = 0; i < 8; ++i) s0r[i] = *(const f32x4*)(S0p + i * 128); }
    LAS float* bs = (LAS float*)(lds + 0); LAS float* kkS = (LAS float*)(lds + 4096); LAS float* qq = (LAS float*)(lds + 8192); LAS float* aq = (LAS float*)(lds + 12288);
    LAS float* kd = (LAS float*)(lds + 16384); LAS float* vv = (LAS float*)(lds + 20480); LAS float* sc = (LAS float*)(lds + 24576); LAS float* part = (LAS float*)(lds + 32768);
    {
        const int c = tid & 127, p = tid >> 7;
        if (p == 0) {
            float run = 0.f;
#pragma unroll
            for (int t = 0; t < 8; ++t) { const float lf = LF[(size_t)(R0 + t) * HW + h * 128 + c]; kkS[t * 128 + c] = 1.f - __expf(lf); run += lf; bs[t * 128 + c] = run; }
#pragma unroll
            for (int t = 0; t < 8; ++t) { const float bt = bs[t * 128 + c]; const float q = bf1(QB[(size_t)(R0 + t) * HW + h * 128 + c]);
                qq[t * 128 + c] = q; aq[t * 128 + c] = q * __expf(bt); kd[t * 128 + c] = kkS[t * 128 + c] * __expf(run - bt); }
        } else if (p == 1) {
#pragma unroll
            for (int t = 0; t < 8; ++t) vv[t * 128 + c] = bf1(VB[(size_t)(R0 + t) * HW + h * 128 + c]);
        }
    }
    __syncthreads();
    {
        const int pair = tid >> 3, t = pair >> 3, s = pair & 7, sub = tid & 7;
        float sum = 0.f;
        if (s <= t) {
#pragma unroll
            for (int e = 0; e < 16; ++e) { const int c = sub * 16 + e; sum += qq[t * 128 + c] * __expf(bs[t * 128 + c] - bs[s * 128 + c]) * kkS[s * 128 + c]; }
        }
        sum += __shfl_xor(sum, 1); sum += __shfl_xor(sum, 2); sum += __shfl_xor(sum, 4);
        if (sub == 0) sc[t * 8 + s] = sum;
    }
    __syncthreads();
    {
        const int v4 = tid & 31, kg = tid >> 5;
        float* SN = out + O_HS + so;
        f32x4 op[8];
#pragma unroll
        for (int t = 0; t < 8; ++t) op[t] = (f32x4){0.f, 0.f, 0.f, 0.f};
#pragma unroll
        for (int i = 0; i < 8; ++i) {
            const int k = 8 * kg + i;
            const f32x4 s0 = s0r[i];
#pragma unroll
            for (int t = 0; t < 8; ++t) op[t] += aq[t * 128 + k] * s0;
            f32x4 sn = s0 * __expf(bs[7 * 128 + k]);
#pragma unroll
            for (int s = 0; s < 8; ++s) sn += kd[s * 128 + k] * (*(const LAS f32x4*)(vv + s * 128 + 4 * v4));
            *(f32x4*)(SN + k * 128 + 4 * v4) = sn;
        }
#pragma unroll
        for (int t = 0; t < 8; ++t) {
#pragma unroll
            for (int e = 0; e < 4; ++e) op[t][e] += __shfl_xor(op[t][e], 32);
            if (lane < 32) *(LAS f32x4*)(part + (wave * 8 + t) * 128 + 4 * v4) = op[t];
        }
    }
    __syncthreads();
    {
        const int t = wave, v = 2 * lane;
        float o0 = 0.f, o1 = 0.f;
#pragma unroll
        for (int w = 0; w < 8; ++w) { o0 += part[(w * 8 + t) * 128 + v]; o1 += part[(w * 8 + t) * 128 + v + 1]; }
        for (int s = 0; s <= t; ++s) { const float p = sc[t * 8 + s]; o0 += p * vv[s * 128 + v]; o1 += p * vv[s * 128 + v + 1]; }
        const float rstd = rsqrtf(wave_sum(o0 * o0 + o1 * o1) * (1.f / 128.f) + RMS_EPS);
        const unsigned g = *(const unsigned*)(GB + (size_t)(R0 + t) * HW + h * 128 + v);
        const float on0 = onorm[layer * HW + h * 128 + v], on1 = onorm[layer * HW + h * 128 + v + 1];
        *(unsigned*)(MIX + (size_t)(R0 + t) * DM + h * 128 + v) = pk(o0 * rstd * on0 * bflo(g), o1 * rstd * on1 * bfhi(g));
    }
}

__device__ __forceinline__ void h3_prompt_units(ldsp lds, int u0, int G, int layer, const float* LF, const bf16* QB, const bf16* VB, const bf16* GB, const float* Sbuf, const float* onorm,
                                                bf16* MIX, int tid, int wave, int lane) {
    if (u0 >= NPU) return;
    H3Pre P; h3pre_issue(P, u0, LF, QB, VB, GB, Sbuf, tid, wave, lane);
    for (int unit = u0; unit < NPU; unit += G) {
        const int bh = unit >> 5, n = unit & 31, b = bh >> 2, h = bh & 3, tok0 = b * SEQ + n * 64;
        __syncthreads();
#pragma unroll
        for (int j = 0; j < 2; ++j) { const int idx = tid + 512 * j, t = idx >> 4, c8 = idx & 15; *(LAS u32x4*)(lds + L_QS + t * RS128 + 16 * c8) = P.q[j]; }
        float kk[16];
        stage_cumsum(lds, P.b, kk, tid);
        LAS float* BS = (LAS float*)(lds + L_BS);
        {
            const int c = tid & 127, sg = tid >> 7;
            const float bref = BS[31 * 128 + c];
#pragma unroll
            for (int i = 0; i < 16; ++i) {
                const int t = sg * 16 + i; const float bt = BS[t * 128 + c];
                const float q = bf1(*(const LAS bf16*)(lds + L_QS + t * RS128 + 2 * c));
                *(LAS bf16*)(lds + L_QS + t * RS128 + 2 * c) = tobf(q * __expf(fminf(bt - bref, 80.f)));
                *(LAS bf16*)(lds + L_KS + t * RS128 + 2 * c) = tobf(kk[i] * __expf(fminf(bref - bt, 80.f)));
            }
        }
        {
            const int v = tid & 127, kg = tid >> 7;
#pragma unroll
            for (int i8 = 0; i8 < 4; ++i8) {
                const int k0 = 32 * kg + 8 * i8;
                float sv[8];
#pragma unroll
                for (int e = 0; e < 8; ++e) sv[e] = P.s[8 * i8 + e] * __expf(BS[31 * 128 + k0 + e]);
                u32x4 w; w.x = pk(sv[0], sv[1]); w.y = pk(sv[2], sv[3]); w.z = pk(sv[4], sv[5]); w.w = pk(sv[6], sv[7]);
                *(LAS u32x4*)(lds + L_ST + v * RS128 + k0 * 2) = w;
            }
        }
        u32x2 gc[4];
#pragma unroll
        for (int i = 0; i < 4; ++i) gc[i] = P.g[i];
        if (unit + G < NPU) h3pre_issue(P, unit + G, LF, QB, VB, GB, Sbuf, tid, wave, lane);
        __syncthreads();
        const int fr = lane & 15, fq = lane >> 4, tm = wave >> 1;
        {
            const int ts0 = (wave & 1) * 2;
            f32x4 sc[2] = {{0.f, 0.f, 0.f, 0.f}, {0.f, 0.f, 0.f, 0.f}};
#pragma unroll
            for (int k2 = 0; k2 < 4; ++k2) {
                const bf16x8 a = *(const LAS bf16x8*)(lds + L_QS + (16 * tm + fr) * RS128 + (32 * k2 + 8 * fq) * 2);
#pragma unroll
                for (int i = 0; i < 2; ++i) { const bf16x8 bb = *(const LAS bf16x8*)(lds + L_KS + (16 * (ts0 + i) + fr) * RS128 + (32 * k2 + 8 * fq) * 2); sc[i] = MFMA16(a, bb, sc[i]); }
            }
#pragma unroll
            for (int i = 0; i < 2; ++i)
#pragma unroll
                for (int j = 0; j < 4; ++j) { const int t = 16 * tm + 4 * fq + j, s2 = 16 * (ts0 + i) + fr;
                    *(LAS bf16*)(lds + L_PP + t * RS64 + 2 * s2) = tobf((s2 <= t) ? sc[i][j] : 0.f); }
        }
        __syncthreads();
        const int vh = wave & 1;
        f32x4 o[4];
#pragma unroll
        for (int i = 0; i < 4; ++i) o[i] = (f32x4){0.f, 0.f, 0.f, 0.f};
#pragma unroll
        for (int k2 = 0; k2 < 4; ++k2) {
            const bf16x8 bq = *(const LAS bf16x8*)(lds + L_QS + (16 * tm + fr) * RS128 + (32 * k2 + 8 * fq) * 2);
#pragma unroll
            for (int i = 0; i < 4; ++i) { const bf16x8 a = *(const LAS bf16x8*)(lds + L_ST + (16 * (4 * vh + i) + fr) * RS128 + (32 * k2 + 8 * fq) * 2); o[i] = MFMA16(a, bq, o[i]); }
        }
#pragma unroll
        for (int k2 = 0; k2 < 2; ++k2) {
            const bf16x8 bp = *(const LAS bf16x8*)(lds + L_PP + (16 * tm + fr) * RS64 + (32 * k2 + 8 * fq) * 2);
#pragma unroll
            for (int i = 0; i < 4; ++i) { const bf16x8 a = *(const LAS bf16x8*)(lds + L_VT + (16 * (4 * vh + i) + fr) * RS64 + (32 * k2 + 8 * fq) * 2); o[i] = MFMA16(a, bp, o[i]); }
        }
        float ss = 0.f;
#pragma unroll
        for (int i = 0; i < 4; ++i) ss += (o[i][0] * o[i][0] + o[i][1] * o[i][1]) + (o[i][2] * o[i][2] + o[i][3] * o[i][3]);
        ss += __shfl_xor(ss, 16); ss += __shfl_xor(ss, 32);
        LAS float* RED = (LAS float*)(lds + L_RED);
        if (fq == 0) RED[vh * 64 + 16 * tm + fr] = ss;
        __syncthreads();
        const float rstd = rsqrtf((RED[16 * tm + fr] + RED[64 + 16 * tm + fr]) * (1.f / 128.f) + RMS_EPS);
        const size_t row = (size_t)(tok0 + 16 * tm + fr);
#pragma unroll
        for (int i = 0; i < 4; ++i) {
            const int vc = h * 128 + 16 * (4 * vh + i) + 4 * fq;
            const f32x4 on = *(const f32x4*)(onorm + layer * HW + vc);
            u32x2 w; w.x = pk(o[i][0] * rstd * on[0] * bflo(gc[i].x), o[i][1] * rstd * on[1] * bfhi(gc[i].x)); w.y = pk(o[i][2] * rstd * on[2] * bflo(gc[i].y), o[i][3] * rstd * on[3] * bfhi(gc[i].y));
            *(u32x2*)(MIX + row * DM + vc) = w;
        }
    }
}

__device__ __forceinline__ void h2_phase(int layer, float* Lbuf, const float* DEC, float* out, const bf16* UB, const bf16* BB, const float* state_conv, const float* conv_w, bf16* MIX, int gtid, int ngt) {
    for (int g = gtid; g < 32 * 4096; g += ngt) {
        const int bh = g >> 12, k = (g >> 5) & 127, v4 = g & 31;
        f32x4 S = {0.f, 0.f, 0.f, 0.f};
        float* Lp = Lbuf + (size_t)bh * 32 * 16384 + k * 128 + 4 * v4;
        const float* dp = DEC + bh * 32 * 128 + k;
        f32x4 l0[8], l1[8]; float d0[8], d1[8];
#pragma unroll
        for (int j = 0; j < 8; ++j) { l0[j] = *(const f32x4*)(Lp + (size_t)j * 16384); d0[j] = dp[j * 128]; }
#pragma unroll
        for (int n0 = 0; n0 < NCHUNK; n0 += 16) {
#pragma unroll
            for (int j = 0; j < 8; ++j) { l1[j] = *(const f32x4*)(Lp + (size_t)(n0 + 8 + j) * 16384); d1[j] = dp[(n0 + 8 + j) * 128]; }
#pragma unroll
            for (int j = 0; j < 8; ++j) { *(f32x4*)(Lp + (size_t)(n0 + j) * 16384) = S; S = S * d0[j] + l0[j]; }
            if (n0 + 16 < NCHUNK) {
#pragma unroll
                for (int j = 0; j < 8; ++j) { l0[j] = *(const f32x4*)(Lp + (size_t)(n0 + 16 + j) * 16384); d0[j] = dp[(n0 + 16 + j) * 128]; }
            }
#pragma unroll
            for (int j = 0; j < 8; ++j) { *(f32x4*)(Lp + (size_t)(n0 + 8 + j) * 16384) = S; S = S * d1[j] + l1[j]; }
        }
        *(f32x4*)(out + O_HP + ((size_t)layer * 32 + bh) * 16384 + k * 128 + 4 * v4) = S;
    }
    for (int g = gtid; g < TT * 64; g += ngt) {
        const int r = g >> 6, c = (g & 63) * 8;
        int t, bsm = -1, row0;
        if (r < TP) { t = r & (SEQ - 1); row0 = r - t; } else { const int q = r - TP; t = q & 7; bsm = q >> 3; row0 = r - t; }
        float u0[8], u1[8], u2[8];
        { const u32x4 w = *(const u32x4*)(UB + (size_t)r * HW + c); u2[0] = bflo(w.x); u2[1] = bfhi(w.x); u2[2] = bflo(w.y); u2[3] = bfhi(w.y); u2[4] = bflo(w.z); u2[5] = bfhi(w.z); u2[6] = bflo(w.w); u2[7] = bfhi(w.w); }
        if (t >= 1) { const u32x4 w = *(const u32x4*)(UB + (size_t)(r - 1) * HW + c); u1[0] = bflo(w.x); u1[1] = bfhi(w.x); u1[2] = bflo(w.y); u1[3] = bfhi(w.y); u1[4] = bflo(w.z); u1[5] = bfhi(w.z); u1[6] = bflo(w.w); u1[7] = bfhi(w.w); }
        else {
#pragma unroll
            for (int e = 0; e < 8; ++e) u1[e] = (bsm >= 0) ? state_conv[(((size_t)layer * 128 + bsm) * 2 + 1) * HW + c + e] : 0.f;
        }
        if (t >= 2) { const u32x4 w = *(const u32x4*)(UB + (size_t)(r - 2) * HW + c); u0[0] = bflo(w.x); u0[1] = bfhi(w.x); u0[2] = bflo(w.y); u0[3] = bfhi(w.y); u0[4] = bflo(w.z); u0[5] = bfhi(w.z); u0[6] = bflo(w.w); u0[7] = bfhi(w.w); }
        else {
#pragma unroll
            for (int e = 0; e < 8; ++e) u0[e] = (bsm >= 0) ? state_conv[(((size_t)layer * 128 + bsm) * 2 + t) * HW + c + e] : 0.f;
        }
        const u32x4 gb = *(const u32x4*)(BB + (size_t)r * HW + c);
        float gv[8] = {bflo(gb.x), bfhi(gb.x), bflo(gb.y), bfhi(gb.y), bflo(gb.z), bfhi(gb.z), bflo(gb.w), bfhi(gb.w)};
        float y[8];
#pragma unroll
        for (int e = 0; e < 8; ++e) { const float w0 = conv_w[(layer * 3 + 0) * HW + c + e], w1 = conv_w[(layer * 3 + 1) * HW + c + e], w2 = conv_w[(layer * 3 + 2) * HW + c + e];
            y[e] = gv[e] * (w0 * u0[e] + w1 * u1[e] + w2 * u2[e]); }
        u32x4 w; w.x = pk(y[0], y[1]); w.y = pk(y[2], y[3]); w.z = pk(y[4], y[5]); w.w = pk(y[6], y[7]);
        *(u32x4*)(MIX + (size_t)r * DM + HW + c) = w;
        (void)row0;
        if (bsm < 0) { if (t >= SEQ - 2) { float* d = out + O_CP + (((size_t)layer * 8 + (r >> 11)) * 2 + (t - (SEQ - 2))) * HW + c;
#pragma unroll
                for (int e = 0; e < 8; ++e) d[e] = u2[e]; } }
        else { if (t >= 6) { float* d = out + O_CS + (((size_t)layer * 128 + bsm) * 2 + (t - 6)) * HW + c;
#pragma unroll
                for (int e = 0; e < 8; ++e) d[e] = u2[e]; } }
    }
}

__device__ __forceinline__ void ln_phase(bf16* X, const float* part, int nsplit, const float* g, const float* bta, float* yout, int gw, int ngw, int lane) {
    for (int r = gw; r < TT; r += ngw) {
        bf16* xr = X + (size_t)r * DM;
        float v[16];
        if (r < TP) {
            const u32x4 a0 = *(const u32x4*)(xr + 8 * lane), a1 = *(const u32x4*)(xr + 512 + 8 * lane);
            v[0] = bflo(a0.x); v[1] = bfhi(a0.x); v[2] = bflo(a0.y); v[3] = bfhi(a0.y); v[4] = bflo(a0.z); v[5] = bfhi(a0.z); v[6] = bflo(a0.w); v[7] = bfhi(a0.w);
            v[8] = bflo(a1.x); v[9] = bfhi(a1.x); v[10] = bflo(a1.y); v[11] = bfhi(a1.y); v[12] = bflo(a1.z); v[13] = bfhi(a1.z); v[14] = bflo(a1.w); v[15] = bfhi(a1.w);
        } else {
#pragma unroll
            for (int e = 0; e < 16; ++e) v[e] = 0.f;
            for (int s = 0; s < nsplit; ++s) {
                const float* pp = part + ((size_t)s * TS + (r - TP)) * DM;
#pragma unroll
                for (int hf = 0; hf < 2; ++hf) { const f32x4 p0 = *(const f32x4*)(pp + hf * 512 + 8 * lane), p1 = *(const f32x4*)(pp + hf * 512 + 8 * lane + 4);
#pragma unroll
                    for (int e = 0; e < 4; ++e) { v[hf * 8 + e] += p0[e]; v[hf * 8 + 4 + e] += p1[e]; } }
            }
        }
        float s = 0.f;
#pragma unroll
        for (int e = 0; e < 16; ++e) s += v[e];
        const float mean = wave_sum(s) * (1.f / DM);
        float s2 = 0.f;
#pragma unroll
        for (int e = 0; e < 16; ++e) { v[e] -= mean; s2 += v[e] * v[e]; }
        const float rstd = rsqrtf(wave_sum(s2) * (1.f / DM) + LN_EPS);
#pragma unroll
        for (int hf = 0; hf < 2; ++hf) {
            const int c = hf * 512 + 8 * lane;
            const f32x4 g0 = *(const f32x4*)(g + c), g1 = *(const f32x4*)(g + c + 4), b0 = *(const f32x4*)(bta + c), b1 = *(const f32x4*)(bta + c + 4);
            f32x4 y0, y1;
#pragma unroll
            for (int e = 0; e < 4; ++e) { y0[e] = v[hf * 8 + e] * rstd * g0[e] + b0[e]; y1[e] = v[hf * 8 + 4 + e] * rstd * g1[e] + b1[e]; }
            u32x4 w; w.x = pk(y0[0], y0[1]); w.y = pk(y0[2], y0[3]); w.z = pk(y1[0], y1[1]); w.w = pk(y1[2], y1[3]);
            *(u32x4*)(xr + c) = w;
            if (yout) { *(f32x4*)(yout + (size_t)r * DM + c) = y0; *(f32x4*)(yout + (size_t)r * DM + c + 4) = y1; }
        }
    }
}

#define RLX_AGENT __ATOMIC_RELAXED, __HIP_MEMORY_SCOPE_AGENT
#define XB_TMO      128
#define XB_XCNT(j)  (256  + 64 * (j))
#define XB_XSUB(j)  (1280 + 64 * (j))
#define XB_XGEN(j)  (2304 + 64 * (j))
#define XB_TOP      3328
#define XB_TOPGEN   3392
#define XCD_BAR_WORDS 3456
#define XB_SPIN_CAP (1u << 18)

__device__ __forceinline__ unsigned xb_ld(unsigned* p)              { return __hip_atomic_load(p, __ATOMIC_RELAXED, __HIP_MEMORY_SCOPE_AGENT); }
__device__ __forceinline__ unsigned xb_add(unsigned* p, unsigned v) { return __hip_atomic_fetch_add(p, v, __ATOMIC_RELAXED, __HIP_MEMORY_SCOPE_AGENT); }
__device__ __forceinline__ unsigned xb_xcc_id() { return (unsigned)__builtin_amdgcn_s_getreg((3 << 11) | 20) & 0xFu; }
#define XB_SPIN(cond, bar) do { unsigned _sp = 0; while (cond) { __builtin_amdgcn_s_sleep(1); \
    if ((++_sp & 255u) == 0u) { if (xb_ld(&(bar)[XB_TMO])) break; if (_sp > XB_SPIN_CAP) { atomicAdd(&(bar)[XB_TMO], 1u); break; } } } } while (0)

struct XcdBarrier {
    unsigned* bar; unsigned x;
    volatile LAS unsigned* st;
};

__device__ __forceinline__ XcdBarrier xcd_barrier_post(unsigned* bar, volatile LAS unsigned* st) {
    XcdBarrier b; b.bar = bar; b.x = xb_xcc_id(); b.st = st;
    if (threadIdx.x == 0) (void)xb_add(&bar[XB_XCNT(b.x)], 1u);
    return b;
}
__device__ __forceinline__ void xcd_barrier_complete(unsigned* bar, unsigned x, unsigned& nloc, unsigned& nx) {
    const unsigned G = gridDim.x * gridDim.y * gridDim.z;
    unsigned sum, cnt, mine, sp = 0u;
    for (;;) {
        sum = 0u; cnt = 0u; mine = 0u;
#pragma unroll
        for (unsigned j = 0; j < 16; ++j) { const unsigned c = xb_ld(&bar[XB_XCNT(j)]); sum += c; cnt += (c > 0u) ? 1u : 0u; mine = (j == x) ? c : mine; }
        if (sum == G) break;
        __builtin_amdgcn_s_sleep(1);
        if ((++sp & 255u) == 0u) { if (xb_ld(&bar[XB_TMO])) break; if (sp > XB_SPIN_CAP) { atomicAdd(&bar[XB_TMO], 1u); break; } }
    }
    nloc = mine > 0u ? mine : 1u; nx = cnt > 0u ? cnt : 1u;
}

__device__ __forceinline__ void xcd_barrier(const XcdBarrier& b) {
    asm volatile("s_waitcnt vmcnt(0)" ::: "memory");
    __syncthreads();
    if (threadIdx.x == 0) {
        unsigned* bar = b.bar;
        __builtin_amdgcn_s_waitcnt(0);
        unsigned nloc = b.st[0], nx = b.st[1];
        if (nloc == 0u) { xcd_barrier_complete(bar, b.x, nloc, nx); b.st[0] = nloc; b.st[1] = nx; }
        const unsigned old = xb_add(&bar[XB_XSUB(b.x)], 1u);
        const unsigned gen = old / nloc;
        if (old + 1u == (gen + 1u) * nloc) {
            __builtin_amdgcn_fence(__ATOMIC_RELEASE, "agent");
            asm volatile("s_waitcnt vmcnt(0)" ::: "memory");
            const unsigned og = xb_add(&bar[XB_TOP], 1u);
            const unsigned tg = og / nx;
            if (og + 1u == (tg + 1u) * nx) xb_add(&bar[XB_TOPGEN], 1u);
            else XB_SPIN(xb_ld(&bar[XB_TOPGEN]) == tg, bar);
            __builtin_amdgcn_fence(__ATOMIC_ACQUIRE, "agent");
            xb_add(&bar[XB_XGEN(b.x)], 1u);
            asm volatile("s_waitcnt vmcnt(0)" ::: "memory");
        } else {
            XB_SPIN(xb_ld(&bar[XB_XGEN(b.x)]) == gen, bar);
            __builtin_amdgcn_fence(__ATOMIC_ACQUIRE, "agent");
            asm volatile("s_waitcnt vmcnt(0)" ::: "memory");
        }
    }
    __syncthreads();
}

struct Args { const float* in[15]; float* out; unsigned char* ws; int ph_lo, ph_hi; };
__global__ void __launch_bounds__(512, 2) mk_fwd(Args a) {
    extern __shared__ __attribute__((aligned(16))) unsigned char lds_raw[];
    ldsp lds = (ldsp)lds_raw;
    cg::grid_group grid = cg::this_grid();
    const int G = gridDim.x, bx = blockIdx.x;
    volatile LAS unsigned* bst = (volatile LAS unsigned*)(lds + LDS_BYTES - 64);
    if (threadIdx.x < 2) bst[threadIdx.x] = 0u;
    __syncthreads();
    const XcdBarrier bar = xcd_barrier_post((unsigned*)a.ws + CW_BAR, bst);
    for (int ph = a.ph_lo; ph < a.ph_hi; ++ph) {
        int tid = threadIdx.x; asm volatile("" : "+v"(tid));
        unsigned char* ws = a.ws; asm volatile("" : "+s"(ws));
        float* out = a.out; asm volatile("" : "+s"(out));
        const int lane = tid & 63, wave = __builtin_amdgcn_readfirstlane(tid >> 6);
        const int gw = bx * 8 + wave, ngw = G * 8;
        bf16* XB = (bf16*)(ws + WS_XB); bf16* MIX = (bf16*)(ws + WS_MIX); bf16* X1 = (bf16*)out; float* Lbuf = out; float* DEC = (float*)(ws + WS_DEC);
        bf16* QB = (bf16*)(ws + WS_QB); float* LF = (float*)(ws + WS_LF); bf16* VB = (bf16*)(ws + WS_VB); bf16* GB = (bf16*)(ws + WS_GB); bf16* BB = (bf16*)(ws + WS_BB); bf16* UB = (bf16*)(ws + WS_UB);
        bf16* HID = (bf16*)(ws + WS_HID);
        if (ph == 0 && (PHMASK & 512)) {
            p0_phase(lds, a.in, ws, gw, ngw, wave, lane);
        } else {
            const int layer = (ph - 1) / 9, kind = (ph - 1) % 9;
            const unsigned char* wl = ws + WS_W + (size_t)layer * W_LAYER;
            if (kind == 0 && (PHMASK & 1)) {
                pg8::Gemm g{(const bf16*)XB, (const bf16*)(wl + W_IN), TT, PW, DM, DM}; pg8::StaticOrder S; S.init(TT, PW, G, bx);
                EpiProj E{QB, VB, GB, BB, UB, LF, a.in[5], layer};
                pg8::gemm_phase<EpiProj, pg8::StaticOrder, true, true>(lds, g, S, E);
            } else if (kind == 1 && (PHMASK & 2)) {
                h1_prompt_units(lds, bx, G, LF, VB, Lbuf, DEC, tid, wave, lane);
                for (int u = bx + ((NPU - bx + G - 1) / G) * G; u < NPU + NSU; u += G) { __syncthreads(); h_sample_unit(lds, u - NPU, layer, LF, QB, VB, GB, a.in[2], a.in[7], MIX, out, tid, wave, lane); }
            } else if (kind == 2 && (PHMASK & 4)) {
                h2_phase(layer, Lbuf, DEC, out, UB, BB, a.in[3], a.in[6], MIX, bx * 512 + tid, G * 512);
            } else if (kind == 3 && (PHMASK & 8)) {
                h3_prompt_units(lds, bx, G, layer, LF, QB, VB, GB, Lbuf, a.in[7], MIX, tid, wave, lane);
            } else if ((kind == 4 || kind == 7) && (PHMASK & 16)) {
                const bool second = (kind == 7);
                const bf16* Aop = second ? (const bf16*)HID : (const bf16*)MIX; const bf16* Bop = (const bf16*)(wl + (second ? W_FF2 : W_OUT)); const int Kfull = second ? FF : DM;
                {
                    pg8::Gemm g{Aop, Bop, TP, DM, Kfull, Kfull}; pg8::StaticOrder S; S.init(TP, DM, G, bx);
                    EpiRes E{second ? (const bf16*)X1 : (const bf16*)XB, second ? XB : X1};
                    pg8::gemm_phase<EpiRes, pg8::StaticOrder, true, true>(lds, g, S, E);
                }
                {
                    const int nsplit = second ? NSPLIT4 : NSPLIT2;
                    pg8::Gemm g{Aop, Bop, TT, DM, Kfull / nsplit, Kfull}; pg8::SplitOrder S; S.init(TP / 256, TS / 256, DM, nsplit, G, bx);
                    EpiPart E{(float*)(ws + (second ? WS_PART4 : WS_PART2)), second ? (const bf16*)X1 : (const bf16*)XB};
                    pg8::gemm_phase<EpiPart, pg8::SplitOrder, true, true>(lds, g, S, E);
                }
            } else if (kind == 5 && (PHMASK & 32)) {
                ln_phase(X1, (const float*)(ws + WS_PART2), NSPLIT2, a.in[9] + layer * DM, a.in[10] + layer * DM, nullptr, gw, ngw, lane);
            } else if (kind == 6 && (PHMASK & 64)) {
                pg8::Gemm g{(const bf16*)X1, (const bf16*)(wl + W_FF1), TT, FF, DM, DM}; pg8::StaticOrder S; S.init(TT, FF, G, bx);
                EpiRelu2 E{HID};
                pg8::gemm_phase<EpiRelu2, pg8::StaticOrder, true, true>(lds, g, S, E);
            } else if (PHMASK & 256) {
                ln_phase(XB, (const float*)(ws + WS_PART4), NSPLIT4, a.in[13] + layer * DM, a.in[14] + layer * DM, (layer == 1) ? out + O_Y : nullptr, gw, ngw, lane);
            }
        }
        if (ph + 1 < a.ph_hi) { if (ph == a.ph_lo) grid.sync(); else xcd_barrier(bar); }
    }
}

extern "C" void kernel_launch(void* const* d_in, const int* in_sizes, int n_in, void* d_out, int out_size, void* d_ws, size_t ws_size, hipStream_t stream) {
    static int grid = 0;
    if (grid == 0) {
        if (n_in != 15 || in_sizes[0] != TP * DM || (size_t)out_size != O_END || ws_size < WS_END) {
            fprintf(stderr, "kernel_launch: unexpected shapes (n_in %d in0 %d out %d ws %zu); nothing launched\n", n_in, n_in > 0 ? in_sizes[0] : -1, out_size, ws_size); grid = -1; return; }
        int dev = 0, cus = 0, per_cu = 0;
        (void)hipGetDevice(&dev); (void)hipDeviceGetAttribute(&cus, hipDeviceAttributeMultiprocessorCount, dev);
        if (hipFuncSetAttribute((const void*)mk_fwd, hipFuncAttributeMaxDynamicSharedMemorySize, LDS_BYTES) != hipSuccess) { fprintf(stderr, "kernel_launch: hipFuncSetAttribute failed\n"); grid = -1; return; }
        if (hipOccupancyMaxActiveBlocksPerMultiprocessor(&per_cu, (const void*)mk_fwd, 512, LDS_BYTES) != hipSuccess || per_cu < 1) { fprintf(stderr, "kernel_launch: occupancy query says %d\n", per_cu); per_cu = 1; }
        (void)hipGetLastError();
        grid = cus > 0 ? cus : 256;
    }
    if (grid < 0) return;
    if (hipMemsetAsync(d_ws, 0, 65536, stream) != hipSuccess) { fprintf(stderr, "kernel_launch: memset failed\n"); return; }
    Args a{};
    for (int i = 0; i < 15; ++i) a.in[i] = (const float*)d_in[i];
    a.out = (float*)d_out; a.ws = (unsigned char*)d_ws;
    for (int lo = 0; lo < NPHASE; lo += (MK_N_LAUNCHES == 1 ? NPHASE : 1))
      for (int rep = 0; rep < ((MK_N_LAUNCHES != 1 && lo > 0 && ((REPMASK >> ((lo - 1) % 9)) & 1)) ? 2 : 1); ++rep) {
        a.ph_lo = lo; a.ph_hi = (MK_N_LAUNCHES == 1) ? NPHASE : lo + 1;
        void* args[] = {&a};
        const hipError_t e = hipLaunchCooperativeKernel((const void*)mk_fwd, dim3(grid), dim3(512), args, LDS_BYTES, stream);
        if (e != hipSuccess) { fprintf(stderr, "kernel_launch: cooperative launch failed: %s (grid %d)\n", hipGetErrorString(e), grid); break; }
    }
}
```
